# Optimizing an MI355X kernel written in HIP

```python
import math
import jax, jax.numpy as jnp
from jax import lax
import numpy as np

D_MODEL = 1024
BATCH = 8
SEQ = 4096
DEPTH = 4
DEC_BATCH = 2
DEC_SEQ = 8192
PAST_LEN = 128

N_MIXERS = 2
N_A_LAYERS = (DEPTH + 1) // 2
N_B_LAYERS = DEPTH // 2

A_HEADS = 8
A_Q_LORA = 384
A_KV_LORA = 256
A_NOPE = 128
A_ROPE = 64
A_V = 128
A_WIDTH = A_HEADS * A_V
A_IN = A_Q_LORA + A_KV_LORA + A_ROPE + A_WIDTH
ROPE_THETA = 10000.0
Q_BLOCK = 128

B_WIDTH = 2 * D_MODEL
B_GROUPS = 8
B_GROUP_DIM = B_WIDTH // B_GROUPS
B_CHUNK = 128
B_IN = 3 * B_WIDTH

RMS_EPS = 1e-6
LN_EPS = 1e-5

kernel_name = "hybrid_mla_gmlp_encoder"


def rmsnorm(x, g):
    x32 = x.astype(jnp.float32)
    y = x32 * lax.rsqrt(jnp.mean(x32 * x32, axis=-1, keepdims=True) + RMS_EPS)
    return y.astype(x.dtype) * g


def layernorm(x, g, b):
    x32 = x.astype(jnp.float32)
    mu = jnp.mean(x32, axis=-1, keepdims=True)
    xc = x32 - mu
    y = xc * lax.rsqrt(jnp.mean(xc * xc, axis=-1, keepdims=True) + LN_EPS)
    return y.astype(x.dtype) * g + b


def rope_tables(seq, dtype):
    inv = ROPE_THETA ** (-jnp.arange(0, A_ROPE, 2, dtype=jnp.float32) / A_ROPE)
    ang = jnp.arange(seq, dtype=jnp.float32)[:, None] * inv[None, :]
    ang = jnp.concatenate([ang, ang], axis=-1)
    return jnp.cos(ang).astype(dtype), jnp.sin(ang).astype(dtype)


def apply_rope(x, cos, sin):
    half = A_ROPE // 2
    x1, x2 = x[..., :half], x[..., half:]
    rot = jnp.concatenate([-x2, x1], axis=-1)
    return x * cos + rot * sin


def mla_attention(q_nope, q_rope, k_nope, k_rope, v):
    bsz, seq = q_nope.shape[0], q_nope.shape[1]
    nb = seq // Q_BLOCK
    scale = (A_NOPE + A_ROPE) ** -0.5

    def blocks(t):
        return jnp.moveaxis(t.reshape(bsz, nb, Q_BLOCK, *t.shape[2:]), 1, 0)

    def one_block(qb):
        qn, qr = qb
        s = (jnp.einsum('bqhd,bkhd->bhqk', qn, k_nope)
             + jnp.einsum('bqhr,bkr->bhqk', qr, k_rope))
        p = jax.nn.softmax(s.astype(jnp.float32) * scale, axis=-1).astype(v.dtype)
        return jnp.einsum('bhqk,bkhd->bqhd', p, v)

    o = lax.map(one_block, (blocks(q_nope), blocks(q_rope)))
    return jnp.moveaxis(o, 0, 1).reshape(bsz, seq, A_WIDTH)


def mla_layer(x, g, w_in, q_norm, kv_norm, w_q_up, w_kv_up, w_out):
    bsz, seq, _ = x.shape
    h = rmsnorm(x, g)
    proj = h @ w_in
    q_lat, kv_lat, k_rope, gate = jnp.split(
        proj, [A_Q_LORA, A_Q_LORA + A_KV_LORA, A_Q_LORA + A_KV_LORA + A_ROPE], axis=-1)
    q = (rmsnorm(q_lat, q_norm) @ w_q_up).reshape(bsz, seq, A_HEADS, A_NOPE + A_ROPE)
    kv = (rmsnorm(kv_lat, kv_norm) @ w_kv_up).reshape(bsz, seq, A_HEADS, A_NOPE + A_V)
    q_nope, q_rope = q[..., :A_NOPE], q[..., A_NOPE:]
    k_nope, v = kv[..., :A_NOPE], kv[..., A_NOPE:]
    cos, sin = rope_tables(seq, x.dtype)
    q_rope = apply_rope(q_rope, cos[:, None, :], sin[:, None, :])
    k_rope = apply_rope(k_rope, cos, sin)
    o = mla_attention(q_nope, q_rope, k_nope, k_rope, v)
    return x + (o * jax.nn.silu(gate)) @ w_out


def gmlp_layer(x, g, w_in, ln_g, ln_b, w_s, b_s, w_out):
    bsz, seq, _ = x.shape
    nc = seq // B_CHUNK
    h = rmsnorm(x, g)
    u, v, gate = jnp.split(h @ w_in, 3, axis=-1)
    u = jax.nn.gelu(u, approximate=False)
    v = layernorm(jax.nn.gelu(v, approximate=False), ln_g, ln_b)
    vc = v.reshape(bsz, nc, B_CHUNK, B_GROUPS, B_GROUP_DIM)
    sv = jnp.einsum('gpq,bnqgd->bnpgd', w_s, vc) + jnp.transpose(b_s)[:, :, None]
    s = u * sv.reshape(bsz, seq, B_WIDTH)
    return x + (s * jax.nn.silu(gate)) @ w_out


def trunk(x, norm_g, final_g,
          a_w_in, a_q_norm, a_kv_norm, a_w_q_up, a_w_kv_up, a_w_out,
          b_w_in, b_ln_g, b_ln_b, b_w_s, b_b_s, b_w_out):
    for i in range(DEPTH):
        j = i // N_MIXERS
        if i % N_MIXERS == 0:
            x = mla_layer(x, norm_g[i], a_w_in[j], a_q_norm[j], a_kv_norm[j],
                          a_w_q_up[j], a_w_kv_up[j], a_w_out[j])
        else:
            x = gmlp_layer(x, norm_g[i], b_w_in[j], b_ln_g[j], b_ln_b[j],
                           b_w_s[j], b_b_s[j], b_w_out[j])
    return rmsnorm(x, final_g)


def setup_inputs(seed: int = 0) -> dict:
    key = jax.random.key(seed)
    ks = jax.random.split(key, 20)
    f32 = jnp.float32

    def nrm(k, shape, scale):
        return jax.random.normal(k, shape, f32) * scale

    return {
        "x_prompt": nrm(ks[0], (BATCH, SEQ, D_MODEL), 1.0),
        "x_sample": nrm(ks[1], (DEC_BATCH, DEC_SEQ, D_MODEL), 1.0),
        "norm_g": 1.0 + nrm(ks[2], (DEPTH, D_MODEL), 0.02),
        "final_g": 1.0 + nrm(ks[3], (D_MODEL,), 0.02),
        "a_w_in": nrm(ks[4], (N_A_LAYERS, D_MODEL, A_IN), D_MODEL ** -0.5),
        "a_q_norm": 1.0 + nrm(ks[5], (N_A_LAYERS, A_Q_LORA), 0.02),
        "a_kv_norm": 1.0 + nrm(ks[6], (N_A_LAYERS, A_KV_LORA), 0.02),
        "a_w_q_up": nrm(ks[7], (N_A_LAYERS, A_Q_LORA, A_HEADS * (A_NOPE + A_ROPE)), A_Q_LORA ** -0.5),
        "a_w_kv_up": nrm(ks[8], (N_A_LAYERS, A_KV_LORA, A_HEADS * (A_NOPE + A_V)), A_KV_LORA ** -0.5),
        "a_w_out": nrm(ks[9], (N_A_LAYERS, A_WIDTH, D_MODEL), A_WIDTH ** -0.5),
        "b_w_in": nrm(ks[10], (N_B_LAYERS, D_MODEL, B_IN), D_MODEL ** -0.5),
        "b_ln_g": 1.0 + nrm(ks[11], (N_B_LAYERS, B_WIDTH), 0.02),
        "b_ln_b": nrm(ks[12], (N_B_LAYERS, B_WIDTH), 0.02),
        "b_w_s": nrm(ks[13], (N_B_LAYERS, B_GROUPS, B_CHUNK, B_CHUNK), B_CHUNK ** -0.5),
        "b_b_s": 1.0 + nrm(ks[14], (N_B_LAYERS, B_GROUPS, B_CHUNK), 0.02),
        "b_w_out": nrm(ks[15], (N_B_LAYERS, B_WIDTH, D_MODEL), B_WIDTH ** -0.5),
    }


def reference(x_prompt, x_sample, norm_g, final_g,
              a_w_in, a_q_norm, a_kv_norm, a_w_q_up, a_w_kv_up, a_w_out,
              b_w_in, b_ln_g, b_ln_b, b_w_s, b_b_s, b_w_out):
    y_prompt = trunk(x_prompt, norm_g, final_g,
                     a_w_in, a_q_norm, a_kv_norm, a_w_q_up, a_w_kv_up, a_w_out,
                     b_w_in, b_ln_g, b_ln_b, b_w_s, b_b_s, b_w_out)
    y_sample = trunk(x_sample, norm_g, final_g,
                     a_w_in, a_q_norm, a_kv_norm, a_w_q_up, a_w_kv_up, a_w_out,
                     b_w_in, b_ln_g, b_ln_b, b_w_s, b_b_s, b_w_out)
    return (y_prompt, y_sample)
```

```cpp
#include <hip/hip_runtime.h>
#include <hip/hip_cooperative_groups.h>
#include <hip/hip_bf16.h>
#include <cstdio>
#include <cstdint>
namespace cg = cooperative_groups;
namespace pg8 {
#define PG8_LAS __attribute__((address_space(3)))
typedef unsigned short bf16_t;
typedef short bf16x8 __attribute__((ext_vector_type(8)));
typedef float f32x4 __attribute__((ext_vector_type(4)));
typedef unsigned u32x4 __attribute__((ext_vector_type(4)));
constexpr int BM = 256, BK = 64, HALF = 128, HTB = HALF * BK * 2  , STAGE_BYTES = 8 * HTB, NXCD = 8, WGM = 8;

__host__ __device__ __forceinline__ int lds_byte(int r, int c) { const int st = (r >> 4) * 2 + (c >> 5), rr = r & 15, cc = c & 31, ob = rr * 64 + cc * 2; return st * 1024 + (ob ^ (((ob >> 9) & 1) << 5)); }
__host__ __device__ __forceinline__ void stage_rc(int b, int& R, int& C) { const int st = b / 1024, sb = b % 1024, swz = sb ^ (((sb >> 9) & 1) << 5); R = (st >> 1) * 16 + swz / 64; C = (st & 1) * 32 + (swz % 64) / 2; }
__host__ __device__ __forceinline__ int perm32(int rho) { const int n = rho >> 4, i = rho & 15; return 8 * (i >> 2) + 4 * n + (i & 3); }

struct Unit { int pm, pn; };
struct Gemm { const bf16_t* A; const bf16_t* Bt; int M, N, K; };

struct StaticOrder {
    int nM, nN, nwg, G, c;
    __host__ __device__ void init(int M, int N, int G_, int c_) { nM = M / BM; nN = N / BM; nwg = nM * nN; G = G_; c = c_; }
    __host__ __device__ bool next(int i, Unit& u) const {
        const long L = (long)i * G + c; if (L >= nwg) return false;
        int wgid = (int)L; { const int q = nwg / NXCD, r = nwg % NXCD, xcd = wgid % NXCD, off = wgid / NXCD; wgid = (xcd < r ? xcd * (q + 1) : r * (q + 1) + (xcd - r) * q) + off; }
        const int nig = WGM * nN, gid = wgid / nig, fm = gid * WGM, gsz = (nM - fm) < WGM ? (nM - fm) : WGM;
        u.pm = fm + ((wgid % nig) % gsz); u.pn = (wgid % nig) / gsz; return true;
    }
    __device__ __forceinline__ void a_ready(const Unit&) const {}
    __device__ __forceinline__ void done(const Unit&) const {}
};

__device__ __forceinline__ unsigned cvt_pk_bf16(float lo, float hi) { unsigned r; asm volatile("v_cvt_pk_bf16_f32 %0, %1, %2" : "=v"(r) : "v"(lo), "v"(hi)); return r; }
typedef float f32x2 __attribute__((ext_vector_type(2)));
__device__ __forceinline__ f32x2 gelu_pk(f32x2 v) {
    const f32x2 av = __builtin_elementwise_abs(v), d = av * 0.2316418882f + 1.0f;
    f32x2 t; t.x = __builtin_amdgcn_rcpf(d.x); t.y = __builtin_amdgcn_rcpf(d.y);
    f32x2 q = t * 0.5307027145f + (-0.7265760135f); q = q * t + 0.7107068705f; q = q * t + (-0.142248368f); q = q * t + 0.127414796f; q = q * t;
    const f32x2 s = (v * v) * (-0.72134752044f);
    f32x2 e; e.x = __builtin_amdgcn_exp2f(s.x); e.y = __builtin_amdgcn_exp2f(s.y);
    const f32x2 m = v * (q * e), r = v - m;
    f32x2 o; o.x = v.x < 0.f ? m.x : r.x; o.y = v.y < 0.f ? m.y : r.y; return o;
}
typedef float f32x2 __attribute__((ext_vector_type(2)));
__device__ __forceinline__ float silu_f(float x) { return x * __builtin_amdgcn_rcpf(1.0f + __builtin_amdgcn_exp2f(-1.4426950408889634f * x)); }
__device__ __forceinline__ float bf2f(unsigned short b) { return __uint_as_float(((unsigned)b) << 16); }
__device__ __forceinline__ int tok_pos(int row) { return row < 32768 ? (row & 4095) : (row & 8191); }
__device__ __forceinline__ void store8(bf16_t* p, const f32x4 a, const f32x4 b) {
    u32x4 w; w.x = cvt_pk_bf16(a[0], a[1]); w.y = cvt_pk_bf16(a[2], a[3]); w.z = cvt_pk_bf16(b[0], b[1]); w.w = cvt_pk_bf16(b[2], b[3]); *(u32x4*)p = w; }
__device__ __forceinline__ void rope8(f32x4& a, f32x4& b, const f32x2* tab  ) {
    const f32x2 t0 = tab[0], t1 = tab[1], t2 = tab[2], t3 = tab[3];
    f32x4 oa, ob;
    oa[0] = a[0] * t0.x - a[1] * t0.y; oa[1] = a[1] * t0.x + a[0] * t0.y;
    oa[2] = a[2] * t1.x - a[3] * t1.y; oa[3] = a[3] * t1.x + a[2] * t1.y;
    ob[0] = b[0] * t2.x - b[1] * t2.y; ob[1] = b[1] * t2.x + b[0] * t2.y;
    ob[2] = b[2] * t3.x - b[3] * t3.y; ob[3] = b[3] * t3.x + b[2] * t3.y;
    a = oa; b = ob;
}
typedef unsigned long long fx_t;
__device__ __forceinline__ void fx_add(fx_t* p, float v) { atomicAdd(p, (fx_t)(long long)(v * 16777216.0f)); }
__device__ __forceinline__ float fx_get(const fx_t* p) { const fx_t v = *p; return (float)(int)(v >> 32) * 256.0f + (float)(unsigned)v * 5.9604644775390625e-8f; }
__device__ __forceinline__ float sq4(const f32x4 v) { return (v[0] * v[0] + v[1] * v[1]) + (v[2] * v[2] + v[3] * v[3]); }
__device__ __forceinline__ float sum4(const f32x4 v) { return (v[0] + v[1]) + (v[2] + v[3]); }

struct EpiAIn {
    static constexpr bool PERM = true, AFTER_DRAIN = false;
    bf16_t* qlat; bf16_t* kvlat; bf16_t* krope; bf16_t* gate; fx_t* ssq_q; fx_t* ssq_kv; const f32x2* rope; const fx_t* ssq_x;
    __device__ __forceinline__ void operator()(const f32x4 (&acc)[2][2][4][2], const Unit& u, int wr, int wc, int fr, int fq) const {
        const int pn = u.pn, cw = wc * 32 + 8 * fq, row0 = u.pm * BM + wr * 64 + fr;
        float rsx[2][4];
#pragma unroll
        for (int ai = 0; ai < 2; ++ai)
#pragma unroll
            for (int m = 0; m < 4; ++m) rsx[ai][m] = fx_get(ssq_x + row0 + ai * HALF + m * 16);
#pragma unroll
        for (int ai = 0; ai < 2; ++ai)
#pragma unroll
            for (int m = 0; m < 4; ++m) rsx[ai][m] = __builtin_amdgcn_rsqf(rsx[ai][m] * (1.0f / 1024.0f) + 1e-6f);
        const bool do_rope = (pn == 2) && (wc < 2);
#pragma unroll
        for (int ai = 0; ai < 2; ++ai) {
            f32x2 rp[4][4];
            if (do_rope) {
#pragma unroll
                for (int m = 0; m < 4; ++m) { const f32x2* t = rope + (size_t)tok_pos(row0 + ai * HALF + m * 16) * 32 + (cw >> 1);
#pragma unroll
                    for (int k = 0; k < 4; ++k) rp[m][k] = t[k]; }
            }
#pragma unroll
            for (int m = 0; m < 4; ++m) {
                const int row = row0 + ai * HALF + m * 16;
                const float rs_ = rsx[ai][m];
                if (pn <= 1) {
                    bf16_t* dst = (pn == 0) ? (kvlat + (size_t)row * 256) : (qlat + (size_t)row * 384);
                    float ss = 0.f;
#pragma unroll
                    for (int bj = 0; bj < 2; ++bj) { const f32x4 a = acc[ai][bj][m][0] * rs_, b = acc[ai][bj][m][1] * rs_; ss += sq4(a) + sq4(b); store8(dst + bj * HALF + cw, a, b); }
                    ss += __shfl_xor(ss, 16); ss += __shfl_xor(ss, 32);
                    if (fq == 0) fx_add((pn == 0 ? ssq_kv : ssq_q) + row, ss);
                } else if (pn == 2) {
                    { const f32x4 a = acc[ai][0][m][0] * rs_, b = acc[ai][0][m][1] * rs_; float ss = sq4(a) + sq4(b); store8(qlat + (size_t)row * 384 + 256 + cw, a, b);
                      ss += __shfl_xor(ss, 16); ss += __shfl_xor(ss, 32); if (fq == 0) fx_add(ssq_q + row, ss); }
                    if (do_rope) { f32x4 a = acc[ai][1][m][0] * rs_, b = acc[ai][1][m][1] * rs_; rope8(a, b, rp[m]); store8(krope + (size_t)row * 64 + cw, a, b); }
                } else {
#pragma unroll
                    for (int bj = 0; bj < 2; ++bj) { f32x4 a = acc[ai][bj][m][0] * rs_, b = acc[ai][bj][m][1] * rs_;
#pragma unroll
                        for (int j = 0; j < 4; ++j) { a[j] = silu_f(a[j]); b[j] = silu_f(b[j]); }
                        store8(gate + (size_t)row * 1024 + (pn - 3) * 256 + bj * HALF + cw, a, b); }
                }
            }
        }
    }
};
struct EpiQUp {
    static constexpr bool PERM = true, AFTER_DRAIN = false;
    bf16_t* Q0; bf16_t* Q1; const fx_t* ssq_q; const f32x2* rope;
    __device__ __forceinline__ void operator()(const f32x4 (&acc)[2][2][4][2], const Unit& u, int wr, int wc, int fr, int fq) const {
        { int l_; asm volatile("v_mbcnt_lo_u32_b32 %0, -1, 0\n\tv_mbcnt_hi_u32_b32 %0, -1, %0" : "=v"(l_)); fr = l_ & 15; fq = l_ >> 4; }
        const int row0 = u.pm * BM + wr * 64 + fr; bf16_t* Q = (u.pm < 128) ? Q0 : Q1;
        float rstd[2][4];
#pragma unroll
        for (int ai = 0; ai < 2; ++ai)
#pragma unroll
            for (int m = 0; m < 4; ++m) rstd[ai][m] = fx_get(ssq_q + row0 + ai * HALF + m * 16);
#pragma unroll
        for (int ai = 0; ai < 2; ++ai)
#pragma unroll
            for (int m = 0; m < 4; ++m) rstd[ai][m] = __builtin_amdgcn_rsqf(rstd[ai][m] * (1.0f / 384.0f) + 1e-6f);
#pragma unroll
        for (int bj = 0; bj < 2; ++bj) {
            const int c0 = u.pn * BM + bj * HALF + wc * 32 + 8 * fq, d = c0 % 192;
#pragma unroll
            for (int ai = 0; ai < 2; ++ai) {
                f32x2 rp[4][4];
                if (d >= 128) {
#pragma unroll
                    for (int m = 0; m < 4; ++m) { const f32x2* t = rope + (size_t)tok_pos(row0 + ai * HALF + m * 16) * 32 + ((d - 128) >> 1);
#pragma unroll
                        for (int k = 0; k < 4; ++k) rp[m][k] = t[k]; }
                }
#pragma unroll
                for (int m = 0; m < 4; ++m) {
                    const int row = row0 + ai * HALF + m * 16;
                    f32x4 a = acc[ai][bj][m][0] * rstd[ai][m], b = acc[ai][bj][m][1] * rstd[ai][m];
                    if (d >= 128) rope8(a, b, rp[m]);
                    store8(Q + (size_t)row * 1536 + c0, a, b);
                }
            }
        }
    }
};
struct EpiKvUp {
    static constexpr bool PERM = true, AFTER_DRAIN = false;
    bf16_t* KV0; bf16_t* KV1; const fx_t* ssq_kv;
    __device__ __forceinline__ void operator()(const f32x4 (&acc)[2][2][4][2], const Unit& u, int wr, int wc, int fr, int fq) const {
        const int row0 = u.pm * BM + wr * 64 + fr; bf16_t* KV = (u.pm < 128) ? KV0 : KV1;
        float rstd[2][4];
#pragma unroll
        for (int ai = 0; ai < 2; ++ai)
#pragma unroll
            for (int m = 0; m < 4; ++m) rstd[ai][m] = fx_get(ssq_kv + row0 + ai * HALF + m * 16);
#pragma unroll
        for (int ai = 0; ai < 2; ++ai)
#pragma unroll
            for (int m = 0; m < 4; ++m) {
                const int row = row0 + ai * HALF + m * 16;
                const float r_ = __builtin_amdgcn_rsqf(rstd[ai][m] * (1.0f / 256.0f) + 1e-6f);
#pragma unroll
                for (int bj = 0; bj < 2; ++bj) {
                    const int c0 = u.pn * BM + bj * HALF + wc * 32 + 8 * fq;
                    store8(KV + (size_t)row * 2048 + c0, acc[ai][bj][m][0] * r_, acc[ai][bj][m][1] * r_);
                }
            }
    }
};
struct EpiResid {
    static constexpr bool PERM = true, AFTER_DRAIN = false;
    const bf16_t* Xin; bf16_t* Xout; float* outf; fx_t* ssqn;
    __device__ __forceinline__ void operator()(const f32x4 (&acc)[2][2][4][2], const Unit& u, int wr, int wc, int fr, int fq) const {
        const int col = u.pn * BM + wc * 32 + 8 * fq, row0 = u.pm * BM + wr * 64 + fr;
        u32x4 xr[2][4][2];
#pragma unroll
        for (int ai = 0; ai < 2; ++ai)
#pragma unroll
            for (int m = 0; m < 4; ++m)
#pragma unroll
                for (int bj = 0; bj < 2; ++bj) xr[ai][m][bj] = *(const u32x4*)(Xin + (size_t)(row0 + ai * HALF + m * 16) * 1024 + col + bj * HALF);
#pragma unroll
        for (int ai = 0; ai < 2; ++ai)
#pragma unroll
            for (int m = 0; m < 4; ++m) {
                const int row = row0 + ai * HALF + m * 16;
                const size_t off = (size_t)row * 1024 + col;
                float ss = 0.f;
#pragma unroll
                for (int bj = 0; bj < 2; ++bj) {
                    const u32x4 xb = xr[ai][m][bj];
                    const f32x4 x0 = {__uint_as_float(xb.x << 16), __uint_as_float(xb.x & 0xffff0000u), __uint_as_float(xb.y << 16), __uint_as_float(xb.y & 0xffff0000u)};
                    const f32x4 x1 = {__uint_as_float(xb.z << 16), __uint_as_float(xb.z & 0xffff0000u), __uint_as_float(xb.w << 16), __uint_as_float(xb.w & 0xffff0000u)};
                    const f32x4 y0 = x0 + acc[ai][bj][m][0], y1 = x1 + acc[ai][bj][m][1];
                    if (outf) { *(f32x4*)(outf + off + bj * HALF) = y0; *(f32x4*)(outf + off + bj * HALF + 4) = y1; }
                    else { ss += sq4(y0) + sq4(y1); store8(Xout + off + bj * HALF, y0, y1); }
                }
                if (!outf) { ss += __shfl_xor(ss, 16); ss += __shfl_xor(ss, 32); if (fq == 0) fx_add(ssqn + row, ss); }
            }
    }
};
struct EpiBIn {
    static constexpr bool PERM = true, AFTER_DRAIN = false;
    bf16_t* gv0; bf16_t* gv1; bf16_t* ug; fx_t* s1; fx_t* s2; const fx_t* ssq_x;
    __device__ __forceinline__ void operator()(const f32x4 (&acc)[2][2][4][2], const Unit& u, int wr, int wc, int fr, int fq) const {
        const int pn = u.pn, cw = wc * 32 + 8 * fq, row0 = u.pm * BM + wr * 64 + fr;
        float rsx_[2][4];
#pragma unroll
        for (int ai = 0; ai < 2; ++ai)
#pragma unroll
            for (int m = 0; m < 4; ++m) rsx_[ai][m] = fx_get(ssq_x + row0 + ai * HALF + m * 16);
#pragma unroll
        for (int ai = 0; ai < 2; ++ai)
#pragma unroll
            for (int m = 0; m < 4; ++m) {
                const int row = row0 + ai * HALF + m * 16; bf16_t* gv = (u.pm < 128) ? gv0 : gv1;
                const float rsx = __builtin_amdgcn_rsqf(rsx_[ai][m] * (1.0f / 1024.0f) + 1e-6f);
                if (pn < 8) {
                    float a1 = 0.f, a2 = 0.f;
#pragma unroll
                    for (int bj = 0; bj < 2; ++bj) { f32x4 a = acc[ai][bj][m][0] * rsx, b = acc[ai][bj][m][1] * rsx;
                        const f32x2 g0 = gelu_pk((f32x2){a[0], a[1]}), g1 = gelu_pk((f32x2){a[2], a[3]}), g2 = gelu_pk((f32x2){b[0], b[1]}), g3 = gelu_pk((f32x2){b[2], b[3]});
                        a = (f32x4){g0.x, g0.y, g1.x, g1.y}; b = (f32x4){g2.x, g2.y, g3.x, g3.y};
                        a1 += sum4(a) + sum4(b); a2 += sq4(a) + sq4(b);
                        store8(gv + (size_t)row * 2048 + pn * 256 + bj * HALF + cw, a, b); }
                    a1 += __shfl_xor(a1, 16); a1 += __shfl_xor(a1, 32); a2 += __shfl_xor(a2, 16); a2 += __shfl_xor(a2, 32);
                    if (fq == 0) { fx_add(s1 + row, a1); fx_add(s2 + row, a2); }
                } else {
                    f32x4 a = acc[ai][0][m][0] * rsx, b = acc[ai][0][m][1] * rsx; const f32x4 ga = acc[ai][1][m][0] * rsx, gb = acc[ai][1][m][1] * rsx;
                    const f32x2 g0 = gelu_pk((f32x2){a[0], a[1]}), g1 = gelu_pk((f32x2){a[2], a[3]}), g2 = gelu_pk((f32x2){b[0], b[1]}), g3 = gelu_pk((f32x2){b[2], b[3]});
                    a = (f32x4){g0.x * silu_f(ga[0]), g0.y * silu_f(ga[1]), g1.x * silu_f(ga[2]), g1.y * silu_f(ga[3])};
                    b = (f32x4){g2.x * silu_f(gb[0]), g2.y * silu_f(gb[1]), g3.x * silu_f(gb[2]), g3.y * silu_f(gb[3])};
                    store8(ug + (size_t)row * 2048 + (pn - 8) * 128 + cw, a, b);
                }
            }
    }
};
template <class Epi, class Sched, bool ALIGN_EPI = false, bool SP2 = false>
__device__ __forceinline__ void gemm_phase(PG8_LAS unsigned char* lds, const Gemm g, const Sched& S, const Epi& E, const int tid) {
    const int wid = __builtin_amdgcn_readfirstlane(tid >> 6), lane = tid & 63, wr = wid >> 2, wc = wid & 3, fr = lane & 15, fq = lane >> 4;
    const int K = g.K, nt = K / BK;
    unsigned voffA[2], voffB[2];
#pragma unroll
    for (int i = 0; i < 2; ++i) { int R, C; stage_rc(tid * 16 + i * 8192, R, C); const int Rb = Epi::PERM ? ((R & ~31) + perm32(R & 31)) : R;
        voffA[i] = (unsigned)(R * K + C) * 2u; voffB[i] = (unsigned)(Rb * K + C) * 2u; }
    const size_t kstep = (size_t)(BK * 2);
    const size_t hstep = (size_t)HALF * K * 2;
    const size_t tstep = 2 * hstep;
    const unsigned ldsw = (unsigned)wid * 1024u;
    const int aoff = lds_byte(wr * 64 + fr, fq * 8), boff = lds_byte(wc * 32 + fr, fq * 8);
#define PG8_SA(b, h) (((b) * 2 + (h)) * HTB)
#define PG8_SB(b, h) ((4 + (b) * 2 + (h)) * HTB)
#define PG8_STAGE(bufoff, gbase, voff) do { _Pragma("unroll") for (int _i = 0; _i < 2; ++_i) \
        __builtin_amdgcn_global_load_lds((const unsigned*)((const char*)(gbase) + (voff)[_i]), (PG8_LAS unsigned*)(lds + (bufoff) + ldsw + _i * 8192), 16, 0, 0); } while (0)
#define PG8_LDA(dst, b, h) do { _Pragma("unroll") for (int m = 0; m < 4; ++m) _Pragma("unroll") for (int k = 0; k < 2; ++k) dst[m][k] = *(const PG8_LAS bf16x8*)(lds + PG8_SA(b, h) + aoff + m * 2048 + k * 1024); } while (0)
#define PG8_LDB(dst, b, h) do { _Pragma("unroll") for (int n = 0; n < 2; ++n) _Pragma("unroll") for (int k = 0; k < 2; ++k) dst[n][k] = *(const PG8_LAS bf16x8*)(lds + PG8_SB(b, h) + boff + n * 2048 + k * 1024); } while (0)
#define PG8_MMA(ai, bj, At, Bt) do { __builtin_amdgcn_s_setprio(1); _Pragma("unroll") for (int m = 0; m < 4; ++m) _Pragma("unroll") for (int n = 0; n < 2; ++n) _Pragma("unroll") for (int k = 0; k < 2; ++k) \
        acc[ai][bj][m][n] = __builtin_amdgcn_mfma_f32_16x16x32_bf16(Bt[n][k], At[m][k], acc[ai][bj][m][n], 0, 0, 0); __builtin_amdgcn_s_setprio(0); } while (0)
#define PG8_WAIT_V(n) asm volatile("s_waitcnt vmcnt(" #n ")" ::: "memory")
#define PG8_WAIT_L(n) asm volatile("s_waitcnt lgkmcnt(" #n ")" ::: "memory")
#define PG8_BAR __builtin_amdgcn_s_barrier()
#define PG8_SCHED __builtin_amdgcn_sched_barrier(0)
    Unit cur, nxt; int ui = 0;
    if (!S.next(0, cur)) return;
    f32x4 acc[2][2][4][2];
#pragma unroll
    for (int a = 0; a < 2; ++a)
#pragma unroll
        for (int b = 0; b < 2; ++b)
#pragma unroll
            for (int m = 0; m < 4; ++m)
#pragma unroll
                for (int n = 0; n < 2; ++n) acc[a][b][m][n] = (f32x4){0.f, 0.f, 0.f, 0.f};
    bf16x8 At[4][2], B0[2][2], B1[2][2];
    const char* cA = (const char*)g.A + (size_t)cur.pm * tstep; const char* cB = (const char*)g.Bt + (size_t)cur.pn * tstep;
    S.a_ready(cur);
    if constexpr (SP2) {
        PG8_STAGE(PG8_SB(0, 0), cB, voffB); PG8_STAGE(PG8_SB(0, 1), cB + hstep, voffB); PG8_STAGE(PG8_SA(0, 0), cA, voffA); PG8_STAGE(PG8_SA(0, 1), cA + hstep, voffA);
        if (wr == 1) PG8_BAR;
        PG8_WAIT_V(2); PG8_BAR;
        PG8_STAGE(PG8_SB(1, 0), cB + kstep, voffB); PG8_STAGE(PG8_SA(1, 0), cA + kstep, voffA); PG8_STAGE(PG8_SB(1, 1), cB + hstep + kstep, voffB);
        PG8_WAIT_V(6); PG8_BAR;
    } else {
        PG8_STAGE(PG8_SB(0, 0), cB, voffB); PG8_STAGE(PG8_SA(0, 0), cA, voffA); PG8_STAGE(PG8_SB(0, 1), cB + hstep, voffB); PG8_STAGE(PG8_SA(0, 1), cA + hstep, voffA);
        if (wr == 1) PG8_BAR;
        PG8_WAIT_V(4); PG8_BAR;
        PG8_STAGE(PG8_SB(1, 0), cB + kstep, voffB); PG8_STAGE(PG8_SA(1, 0), cA + kstep, voffA); PG8_STAGE(PG8_SB(1, 1), cB + hstep + kstep, voffB);
        PG8_WAIT_V(6); PG8_BAR;
    }
    for (;;) {
        const bool has_next = S.next(ui + 1, nxt);
        const char* nA = has_next ? (const char*)g.A + (size_t)nxt.pm * tstep : cA; const char* nB = has_next ? (const char*)g.Bt + (size_t)nxt.pn * tstep : cB;
        for (int t = 0; t < nt; t += 2) {
            const bool last = (t == nt - 2);
            const char* a1 = cA + (size_t)(t + 1) * kstep;
            const char* a2 = last ? nA : cA + (size_t)(t + 2) * kstep; const char* b2 = last ? nB : cB + (size_t)(t + 2) * kstep;
            const char* a3 = a2 + kstep; const char* b3 = b2 + kstep;
            if (last && has_next) S.a_ready(nxt);
            if constexpr (SP2) {
            PG8_LDB(B0, 0, 0); PG8_LDB(B1, 0, 1); PG8_SCHED; PG8_LDA(At, 0, 0); PG8_STAGE(PG8_SA(1, 1), a1 + hstep, voffA);
            PG8_WAIT_V(8); PG8_WAIT_L(0); PG8_BAR; PG8_MMA(0, 0, At, B0); PG8_MMA(0, 1, At, B1); PG8_BAR; PG8_SCHED;
            PG8_LDA(At, 0, 1); PG8_STAGE(PG8_SB(0, 0), b2, voffB); PG8_STAGE(PG8_SB(0, 1), b2 + hstep, voffB); PG8_STAGE(PG8_SA(0, 0), a2, voffA);
            PG8_WAIT_V(8); PG8_WAIT_L(0); PG8_BAR; PG8_MMA(1, 0, At, B0); PG8_MMA(1, 1, At, B1); PG8_BAR; PG8_SCHED;
            PG8_LDB(B0, 1, 0); PG8_LDB(B1, 1, 1); PG8_SCHED; PG8_LDA(At, 1, 0); PG8_STAGE(PG8_SA(0, 1), a2 + hstep, voffA);
            PG8_WAIT_V(8); PG8_WAIT_L(0); PG8_BAR; PG8_MMA(0, 0, At, B0); PG8_MMA(0, 1, At, B1); PG8_BAR; PG8_SCHED;
            PG8_LDA(At, 1, 1); PG8_STAGE(PG8_SB(1, 0), b3, voffB); PG8_STAGE(PG8_SB(1, 1), b3 + hstep, voffB); PG8_STAGE(PG8_SA(1, 0), a3, voffA);
            PG8_WAIT_V(8); PG8_WAIT_L(0); PG8_BAR; PG8_MMA(1, 0, At, B0); PG8_MMA(1, 1, At, B1); PG8_BAR; PG8_SCHED;
            } else {
            PG8_LDB(B0, 0, 0); PG8_SCHED; PG8_LDA(At, 0, 0); PG8_STAGE(PG8_SA(1, 1), a1 + hstep, voffA);
            PG8_WAIT_L(8); PG8_BAR; PG8_WAIT_L(0); PG8_MMA(0, 0, At, B0); PG8_BAR; PG8_SCHED;
            PG8_LDB(B1, 0, 1); PG8_STAGE(PG8_SB(0, 0), b2, voffB);
            PG8_BAR; PG8_WAIT_L(0); PG8_MMA(0, 1, At, B1); PG8_BAR;
            PG8_LDA(At, 0, 1); PG8_STAGE(PG8_SA(0, 0), a2, voffA);
            PG8_BAR; PG8_WAIT_L(0); PG8_MMA(1, 0, At, B0); PG8_BAR; PG8_SCHED;
            PG8_STAGE(PG8_SB(0, 1), b2 + hstep, voffB);
            PG8_WAIT_V(6); PG8_BAR; PG8_MMA(1, 1, At, B1); PG8_BAR;
            PG8_LDB(B0, 1, 0); PG8_SCHED; PG8_LDA(At, 1, 0); PG8_STAGE(PG8_SA(0, 1), a2 + hstep, voffA);
            PG8_WAIT_L(8); PG8_BAR; PG8_WAIT_L(0); PG8_MMA(0, 0, At, B0); PG8_BAR; PG8_SCHED;
            PG8_LDB(B1, 1, 1); PG8_STAGE(PG8_SB(1, 0), b3, voffB);
            PG8_BAR; PG8_WAIT_L(0); PG8_MMA(0, 1, At, B1); PG8_BAR;
            PG8_LDA(At, 1, 1); PG8_STAGE(PG8_SA(1, 0), a3, voffA);
            PG8_BAR; PG8_WAIT_L(0); PG8_MMA(1, 0, At, B0); PG8_BAR; PG8_SCHED;
            PG8_STAGE(PG8_SB(1, 1), b3 + hstep, voffB);
            PG8_WAIT_V(6); PG8_BAR; PG8_MMA(1, 1, At, B1); PG8_BAR;
            }
        }
        if constexpr (ALIGN_EPI) { if (wr == 0) PG8_BAR; }
        if constexpr (!Epi::AFTER_DRAIN) { E(acc, cur, wr, wc, fr, fq); S.done(cur); }
        if (!has_next) break;
#pragma unroll
        for (int a = 0; a < 2; ++a)
#pragma unroll
            for (int b = 0; b < 2; ++b)
#pragma unroll
                for (int m = 0; m < 4; ++m)
#pragma unroll
                    for (int n = 0; n < 2; ++n) acc[a][b][m][n] = (f32x4){0.f, 0.f, 0.f, 0.f};
        cur = nxt; cA = nA; cB = nB; ++ui;
        if constexpr (ALIGN_EPI) { if (wr == 1) PG8_BAR; }
    }
    PG8_WAIT_V(0);
    if constexpr (!ALIGN_EPI) { if (wr == 0) PG8_BAR; }
    PG8_BAR;
    if constexpr (Epi::AFTER_DRAIN) { E.fused(acc, cur, wr, wc, fr, fq, lds, wid, lane); S.done(cur); }
#undef PG8_SA
#undef PG8_SB
#undef PG8_STAGE
#undef PG8_LDA
#undef PG8_LDB
#undef PG8_MMA
#undef PG8_WAIT_V
#undef PG8_WAIT_L
#undef PG8_BAR
#undef PG8_SCHED
}
}
namespace att {
using bf16x8 = __attribute__((ext_vector_type(8))) short;
using s16x4  = __attribute__((ext_vector_type(4))) short;
using f32x16 = __attribute__((ext_vector_type(16))) float;
using u32x4  = __attribute__((ext_vector_type(4))) unsigned;
typedef unsigned short bf16_t;
constexpr int NW = 8, QBLK = 32, KVBLK = 64;
constexpr float SCALE = 0.07216878364870322f;
constexpr float THR = 8.f;
constexpr int LDQ = 1536, LDKV = 2048, LDKR = 64, LDG = 1024;
constexpr int SHM_V = KVBLK * 128 * 2, SHM_K = KVBLK * 192 * 2, SHM_ATTN = 3 * SHM_V + 3 * SHM_K + NW * 64 * 4 + NW * 4096;
#define KSWZ(row, colB) ((row) * 384 + ((colB) ^ ((((row) >> 1) & 7) << 4)))
#define SBAR() __builtin_amdgcn_sched_barrier(0)
__device__ __forceinline__ int crow(int r, int hi) { return (r & 3) + 8 * (r >> 2) + 4 * hi; }
__device__ __forceinline__ unsigned cvtpk(float lo, float hi) { unsigned r; asm volatile("v_cvt_pk_bf16_f32 %0, %1, %2" : "=v"(r) : "v"(lo), "v"(hi)); return r; }
__device__ __forceinline__ void partialSM(f32x16& p0, f32x16& p1, float& m_reg, float& mn, float& alpha) {
  constexpr float C = SCALE * 1.4426950408889634f;
  float pmax = p0[0];
#pragma unroll
  for (int r = 1; r < 16; ++r) pmax = fmaxf(pmax, p0[r]);
#pragma unroll
  for (int r = 0; r < 16; ++r) pmax = fmaxf(pmax, p1[r]);
  { auto rr = __builtin_amdgcn_permlane32_swap(__float_as_uint(pmax), __float_as_uint(pmax), false, false);
    pmax = fmaxf(__uint_as_float(rr[0]), __uint_as_float(rr[1])); }
  if (__builtin_expect(__all(pmax - m_reg <= THR / SCALE), 1)) { mn = m_reg; alpha = 1.f; }
  else { mn = fmaxf(m_reg, pmax); alpha = __builtin_amdgcn_exp2f((m_reg - mn) * C); m_reg = mn; }
  float mnC = -mn * C;
#pragma unroll
  for (int r = 0; r < 16; ++r) p0[r] = fmaf(p0[r], C, mnC);
#pragma unroll
  for (int r = 0; r < 16; ++r) p1[r] = fmaf(p1[r], C, mnC);
#pragma unroll
  for (int r = 0; r < 16; ++r) p0[r] = __builtin_amdgcn_exp2f(p0[r]);
}
__device__ __forceinline__ void finishSM(f32x16& p0, f32x16& p1, float alpha, float& l_reg, bf16x8& pa0, bf16x8& pa1, bf16x8& pa2, bf16x8& pa3) {
#pragma unroll
  for (int r = 0; r < 16; ++r) p1[r] = __builtin_amdgcn_exp2f(p1[r]);
  float ps = 0;
#pragma unroll
  for (int r = 0; r < 16; ++r) ps += p0[r];
#pragma unroll
  for (int r = 0; r < 16; ++r) ps += p1[r];
  { auto rr = __builtin_amdgcn_permlane32_swap(__float_as_uint(ps), __float_as_uint(ps), false, false);
    ps = __uint_as_float(rr[0]) + __uint_as_float(rr[1]); }
  l_reg = l_reg * alpha + ps;
#define PK4(P, BASE, OUT) do { unsigned a0 = cvtpk(P[BASE + 0], P[BASE + 1]), a1 = cvtpk(P[BASE + 2], P[BASE + 3]);   \
    unsigned b0 = cvtpk(P[BASE + 4], P[BASE + 5]), b1 = cvtpk(P[BASE + 6], P[BASE + 7]);                              \
    auto r0 = __builtin_amdgcn_permlane32_swap(a0, b0, false, false); auto r1 = __builtin_amdgcn_permlane32_swap(a1, b1, false, false); \
    u32x4 w = {r0[0], r1[0], r0[1], r1[1]}; OUT = *reinterpret_cast<bf16x8*>(&w); } while (0)
  PK4(p0, 0, pa0); PK4(p0, 8, pa1); PK4(p1, 0, pa2); PK4(p1, 8, pa3);
#undef PK4
}
__device__ __forceinline__ void qkt(f32x16& p0, f32x16& p1, const char* Ks, const bf16x8* qr, const char* qrl, int r32, int hi) {
  p0 = f32x16{}; p1 = f32x16{};
#pragma unroll
  for (int d0 = 0; d0 < 8; ++d0) { int cb = (d0 * 16 + hi * 8) * 2;
    bf16x8 b0 = *reinterpret_cast<const bf16x8*>(Ks + KSWZ(r32, cb));
    bf16x8 b1 = *reinterpret_cast<const bf16x8*>(Ks + KSWZ(32 + r32, cb));
    p0 = __builtin_amdgcn_mfma_f32_32x32x16_bf16(b0, qr[d0], p0, 0, 0, 0);
    p1 = __builtin_amdgcn_mfma_f32_32x32x16_bf16(b1, qr[d0], p1, 0, 0, 0); }
#pragma unroll
  for (int d0 = 8; d0 < 12; ++d0) { int cb = (d0 * 16 + hi * 8) * 2;
    bf16x8 b0 = *reinterpret_cast<const bf16x8*>(Ks + KSWZ(r32, cb));
    bf16x8 b1 = *reinterpret_cast<const bf16x8*>(Ks + KSWZ(32 + r32, cb));
    bf16x8 qf = *reinterpret_cast<const bf16x8*>(qrl + (((2 * (d0 - 8) + hi) ^ ((r32 >> 1) & 7)) << 4));
    p0 = __builtin_amdgcn_mfma_f32_32x32x16_bf16(b0, qf, p0, 0, 0, 0);
    p1 = __builtin_amdgcn_mfma_f32_32x32x16_bf16(b1, qf, p1, 0, 0, 0); }
}
__device__ __forceinline__ int v_st(int k, int c) { const int kk = (k & ~0xC) | ((k & 4) << 1) | ((k & 8) >> 1); return ((kk >> 3) * 4 + (c >> 5)) * 512 + ((kk & 7) * 32 + (c & 31)) * 2; }
__device__ __forceinline__ int v_rd_base(int lane) { return ((lane & 3) << 3) | (((lane >> 2) & 3) << 6) | (((lane >> 4) & 1) << 5) | (((lane >> 5) & 1) << 8); }
constexpr int v_rd_off(int d0, int ks, int half) { return d0 * 512 + ks * 4096 + half * 2048; }
template <int OFF> __device__ __forceinline__ s16x4 tr_read(int vb) {
  s16x4 r; asm volatile("ds_read_b64_tr_b16 %0, %1 offset:%2" : "=&v"(r) : "v"(vb), "i"(OFF) : "memory"); return r;
}
template <int KS> __device__ __forceinline__ void pv_ks(f32x16* o, int vb, bf16x8 pa) {
  const s16x4 l0 = tr_read<v_rd_off(0, KS, 0)>(vb), h0 = tr_read<v_rd_off(0, KS, 1)>(vb), l1 = tr_read<v_rd_off(1, KS, 0)>(vb), h1 = tr_read<v_rd_off(1, KS, 1)>(vb);
  const s16x4 l2 = tr_read<v_rd_off(2, KS, 0)>(vb), h2 = tr_read<v_rd_off(2, KS, 1)>(vb), l3 = tr_read<v_rd_off(3, KS, 0)>(vb), h3 = tr_read<v_rd_off(3, KS, 1)>(vb);
  asm volatile("s_waitcnt lgkmcnt(0)" ::: "memory"); SBAR();
#define PK(L, H) (bf16x8){L[0], L[1], L[2], L[3], H[0], H[1], H[2], H[3]}
  o[0] = __builtin_amdgcn_mfma_f32_32x32x16_bf16(pa, PK(l0, h0), o[0], 0, 0, 0);
  o[1] = __builtin_amdgcn_mfma_f32_32x32x16_bf16(pa, PK(l1, h1), o[1], 0, 0, 0);
  o[2] = __builtin_amdgcn_mfma_f32_32x32x16_bf16(pa, PK(l2, h2), o[2], 0, 0, 0);
  o[3] = __builtin_amdgcn_mfma_f32_32x32x16_bf16(pa, PK(l3, h3), o[3], 0, 0, 0);
#undef PK
}
__device__ __forceinline__ void pv_d0(f32x16* o, int vb, bf16x8 pa0, bf16x8 pa1, bf16x8 pa2, bf16x8 pa3) {
  pv_ks<0>(o, vb, pa0); pv_ks<1>(o, vb, pa1); pv_ks<2>(o, vb, pa2); pv_ks<3>(o, vb, pa3);
}
__device__ __forceinline__ void attn_unit(const bf16_t* __restrict__ Qb, const bf16_t* __restrict__ Kn, const bf16_t* __restrict__ Vh, const bf16_t* __restrict__ Kr,
                                          bf16_t* GO, int seq, char* lds, const int tid) {
  const int wid = tid >> 6, lane = tid & 63, r32 = lane & 31, hi = lane >> 5;
  char* V_lds = lds; char* K_lds = lds + 3 * SHM_V;
  float* ws = (float*)(lds + 3 * SHM_V + 3 * SHM_K) + wid * 64; float* li_l = ws; float* al_l = ws + 32;
  if (wid < 4) __builtin_amdgcn_s_setprio(2); else __builtin_amdgcn_s_setprio(0);
  float m_reg = -1e30f, l_reg = 0; f32x16 o[4] = {}; bf16x8 qr[8];
  char* qrl = lds + 3 * SHM_V + 3 * SHM_K + NW * 64 * 4 + wid * 4096 + r32 * 128;
  const bf16_t* Qw = Qb + (long)(wid * QBLK + r32) * LDQ + hi * 8;
#pragma unroll
  for (int d0 = 0; d0 < 8; ++d0) qr[d0] = *reinterpret_cast<const bf16x8*>(Qw + d0 * 16);
#pragma unroll
  for (int d0 = 8; d0 < 12; ++d0) *reinterpret_cast<bf16x8*>(qrl + (((2 * (d0 - 8) + hi) ^ ((r32 >> 1) & 7)) << 4)) = *reinterpret_cast<const bf16x8*>(Qw + d0 * 16);
  const int sr = tid >> 4, sc = (tid & 15) * 8, vst0 = v_st(sr, sc), vst1 = v_st(32 + sr, sc);
  const int rr = tid >> 3, rc = (tid & 7) * 8;
  const int vb0 = (int)(uintptr_t)V_lds + v_rd_base(lane);
  const unsigned offkv = (unsigned)(sr * LDKV + sc) * 2u, offkr = (unsigned)(rr * LDKR + rc) * 2u;
  struct { bf16x8 vs0, vs1, ks0, ks1, kr; } sr_[1];
#define SLOAD(i, k0) do { const char* kb_ = (const char*)Kn + (size_t)(k0) * (LDKV * 2); const char* kr_ = (const char*)Kr + (size_t)(k0) * (LDKR * 2); \
    sr_[i].vs0 = *(const bf16x8*)(kb_ + 256 + offkv); sr_[i].vs1 = *(const bf16x8*)(kb_ + 32 * LDKV * 2 + 256 + offkv); \
    sr_[i].ks0 = *(const bf16x8*)(kb_ + offkv); sr_[i].ks1 = *(const bf16x8*)(kb_ + 32 * LDKV * 2 + offkv); \
    sr_[i].kr = *(const bf16x8*)(kr_ + offkr); } while (0)
#define SWRITE(b, i) do { *(bf16x8*)(V_lds + (b) * SHM_V + vst0) = sr_[i].vs0;          \
    *(bf16x8*)(V_lds + (b) * SHM_V + vst1) = sr_[i].vs1; int kc = sc * 2;               \
    *(bf16x8*)(K_lds + (b) * SHM_K + KSWZ(sr, kc)) = sr_[i].ks0;                       \
    *(bf16x8*)(K_lds + (b) * SHM_K + KSWZ(32 + sr, kc)) = sr_[i].ks1;                  \
    *(bf16x8*)(K_lds + (b) * SHM_K + KSWZ(rr, 256 + rc * 2)) = sr_[i].kr; } while (0)
#define SWAIT() asm volatile("s_waitcnt vmcnt(0)" ::: "memory")
#define RESC(a) do { if (__any((a) < 1.f)) { if (hi == 0) al_l[r32] = (a); asm volatile("s_waitcnt lgkmcnt(0)" ::: "memory"); \
    _Pragma("unroll") for (int d = 0; d < 4; ++d) _Pragma("unroll") for (int r = 0; r < 16; ++r) o[d][r] *= al_l[crow(r, hi)]; } } while (0)
  f32x16 pA0, pA1, pB0, pB1; float mnA, mnB, alA, alB; bf16x8 pa0, pa1, pa2, pa3; const int NT = seq / KVBLK;
#define LBAR() do { asm volatile("s_waitcnt lgkmcnt(0)" ::: "memory"); __builtin_amdgcn_s_barrier(); asm volatile("" ::: "memory"); } while (0)
  SLOAD(0, 0); SWRITE(0, 0); SLOAD(0, KVBLK); LBAR();
  qkt(pA0, pA1, K_lds, qr, qrl, r32, hi); partialSM(pA0, pA1, m_reg, mnA, alA);
  SWRITE(1, 0); if (2 < NT) SLOAD(0, 2 * KVBLK); LBAR();
  int bc = 1;
  for (int j = 1; j + 1 < NT; j += 2) {
    const int bp = bc == 0 ? 2 : bc - 1, bn = bc == 2 ? 0 : bc + 1;
    SBAR(); qkt(pB0, pB1, K_lds + bc * SHM_K, qr, qrl, r32, hi);
    finishSM(pA0, pA1, alA, l_reg, pa0, pa1, pa2, pa3); SBAR();
    SWRITE(bn, 0); SLOAD(0, (j + 2) * KVBLK); SBAR();
    pv_d0(o, vb0 + bp * SHM_V, pa0, pa1, pa2, pa3); partialSM(pB0, pB1, m_reg, mnB, alB);
    RESC(alB); LBAR();
    SBAR(); qkt(pA0, pA1, K_lds + bn * SHM_K, qr, qrl, r32, hi);
    finishSM(pB0, pB1, alB, l_reg, pa0, pa1, pa2, pa3); SBAR();
    SWRITE(bp, 0); if (j + 3 < NT) SLOAD(0, (j + 3) * KVBLK); SBAR();
    pv_d0(o, vb0 + bc * SHM_V, pa0, pa1, pa2, pa3); partialSM(pA0, pA1, m_reg, mnA, alA);
    RESC(alA); LBAR();
    bc = bp;
  }
  { const int bp = bc == 0 ? 2 : bc - 1;
    SBAR(); qkt(pB0, pB1, K_lds + bc * SHM_K, qr, qrl, r32, hi);
    finishSM(pA0, pA1, alA, l_reg, pa0, pa1, pa2, pa3); SBAR();
    pv_d0(o, vb0 + bp * SHM_V, pa0, pa1, pa2, pa3); partialSM(pB0, pB1, m_reg, mnB, alB);
    RESC(alB);
    finishSM(pB0, pB1, alB, l_reg, pa0, pa1, pa2, pa3); SBAR();
    pv_d0(o, vb0 + bc * SHM_V, pa0, pa1, pa2, pa3); }
#undef LBAR
  if (hi == 0) li_l[r32] = l_reg; asm volatile("s_waitcnt lgkmcnt(0)" ::: "memory");
  {
    const int erow = lane >> 3, ec8 = (lane & 7) * 8;
    bf16_t* gbase = GO + (long)(wid * QBLK + erow) * LDG + ec8;
    char* stg = qrl - r32 * 128;
    u32x4 gt[2][4];
#pragma unroll
    for (int half = 0; half < 2; ++half)
#pragma unroll
      for (int it = 0; it < 4; ++it) gt[half][it] = *(const u32x4*)(gbase + (long)(it * 8) * LDG + 64 * half);
    float rli[16];
#pragma unroll
    for (int r = 0; r < 16; ++r) rli[r] = __builtin_amdgcn_rcpf(li_l[crow(r, hi)]);
#pragma unroll
    for (int half = 0; half < 2; ++half) {
#pragma unroll
      for (int r = 0; r < 16; ++r) { const int orow = crow(r, hi);
        *(bf16_t*)(stg + orow * 128 + r32 * 2) = (bf16_t)(cvtpk(o[2 * half][r] * rli[r], 0.f) & 0xffffu);
        *(bf16_t*)(stg + orow * 128 + (32 + r32) * 2) = (bf16_t)(cvtpk(o[2 * half + 1][r] * rli[r], 0.f) & 0xffffu); }
      asm volatile("s_waitcnt lgkmcnt(0)" ::: "memory");
#pragma unroll
      for (int it = 0; it < 4; ++it) {
        const u32x4 ov = *(const u32x4*)(stg + (it * 8 + erow) * 128 + ec8 * 2); const u32x4 gv_ = gt[half][it];
        u32x4 w;
#define MULPK(A, B) cvtpk(__uint_as_float((A) << 16) * __uint_as_float((B) << 16), __uint_as_float((A) & 0xffff0000u) * __uint_as_float((B) & 0xffff0000u))
        w.x = MULPK(ov.x, gv_.x); w.y = MULPK(ov.y, gv_.y); w.z = MULPK(ov.z, gv_.z); w.w = MULPK(ov.w, gv_.w);
#undef MULPK
        *(u32x4*)(gbase + (long)(it * 8) * LDG + 64 * half) = w;
      }
      asm volatile("s_waitcnt lgkmcnt(0)" ::: "memory");
    }
  }
  __builtin_amdgcn_s_setprio(0);
#undef SLOAD
#undef SWRITE
#undef SWAIT
#undef RESC
}
}
#define LAS __attribute__((address_space(3)))
typedef unsigned short bf16;
typedef unsigned v4u __attribute__((ext_vector_type(4)));
typedef unsigned v2u __attribute__((ext_vector_type(2)));
typedef float f32x4 __attribute__((ext_vector_type(4)));
typedef float f32x2 __attribute__((ext_vector_type(2)));
typedef short bf16x8 __attribute__((ext_vector_type(8)));
typedef float f32x16 __attribute__((ext_vector_type(16)));
constexpr int NWAVES = 8, NTHR = 512, LDS_MISC = 157696;
#define RLX_AGENT __ATOMIC_RELAXED, __HIP_MEMORY_SCOPE_AGENT
#define XB_TMO      128
#define XB_XCNT(j)  (256  + 64 * (j))
#define XB_XSUB(j)  (1280 + 64 * (j))
#define XB_XGEN(j)  (2304 + 64 * (j))
#define XB_TOP      3328
#define XB_TOPGEN   3392
#define XCD_BAR_WORDS 3456
#define XB_SPIN_CAP (1u << 18)

__device__ __forceinline__ unsigned xb_ld(unsigned* p)              { return __hip_atomic_load(p, __ATOMIC_RELAXED, __HIP_MEMORY_SCOPE_AGENT); }
__device__ __forceinline__ unsigned xb_add(unsigned* p, unsigned v) { return __hip_atomic_fetch_add(p, v, __ATOMIC_RELAXED, __HIP_MEMORY_SCOPE_AGENT); }
__device__ __forceinline__ unsigned xb_xcc_id() { return (unsigned)__builtin_amdgcn_s_getreg((3 << 11) | 20) & 0xFu; }
#define XB_SPIN(cond, bar) do { unsigned _sp = 0; while (cond) { __builtin_amdgcn_s_sleep(1); \
    if ((++_sp & 255u) == 0u) { if (xb_ld(&(bar)[XB_TMO])) break; if (_sp > XB_SPIN_CAP) { atomicAdd(&(bar)[XB_TMO], 1u); break; } } } } while (0)

struct XcdBarrier {
    unsigned* bar; unsigned x;
    volatile LAS unsigned* st;
};

__device__ __forceinline__ XcdBarrier xcd_barrier_post(unsigned* bar, volatile LAS unsigned* st, bool t0) {
    XcdBarrier b; b.bar = bar; b.x = xb_xcc_id(); b.st = st;
    if (t0) (void)xb_add(&bar[XB_XCNT(b.x)], 1u);
    return b;
}
__device__ __forceinline__ void xcd_barrier_complete(unsigned* bar, unsigned x, unsigned& nloc, unsigned& nx) {
    const unsigned G = gridDim.x * gridDim.y * gridDim.z;
    unsigned sum, cnt, mine, sp = 0u;
    for (;;) {
        sum = 0u; cnt = 0u; mine = 0u;
#pragma unroll
        for (unsigned j = 0; j < 16; ++j) { const unsigned c = xb_ld(&bar[XB_XCNT(j)]); sum += c; cnt += (c > 0u) ? 1u : 0u; mine = (j == x) ? c : mine; }
        if (sum == G) break;
        __builtin_amdgcn_s_sleep(1);
        if ((++sp & 255u) == 0u) { if (xb_ld(&bar[XB_TMO])) break; if (sp > XB_SPIN_CAP) { atomicAdd(&bar[XB_TMO], 1u); break; } }
    }
    nloc = mine > 0u ? mine : 1u; nx = cnt > 0u ? cnt : 1u;
}

__device__ __forceinline__ void xcd_barrier(const XcdBarrier& b, bool t0) {
    asm volatile("s_waitcnt vmcnt(0)" ::: "memory");
    __syncthreads();
    if (t0) {
        unsigned* bar = b.bar; asm volatile("" : "+s"(bar));
        __builtin_amdgcn_s_waitcnt(0);
        unsigned nloc = b.st[0], nx = b.st[1];
        if (nloc == 0u) { xcd_barrier_complete(bar, b.x, nloc, nx); b.st[0] = nloc; b.st[1] = nx; }
        const unsigned old = xb_add(&bar[XB_XSUB(b.x)], 1u);
        const unsigned gen = old / nloc;
        if (old + 1u == (gen + 1u) * nloc) {
            __builtin_amdgcn_fence(__ATOMIC_RELEASE, "agent");
            asm volatile("s_waitcnt vmcnt(0)" ::: "memory");
            const unsigned og = xb_add(&bar[XB_TOP], 1u);
            const unsigned tg = og / nx;
            if (og + 1u == (tg + 1u) * nx) xb_add(&bar[XB_TOPGEN], 1u);
            else XB_SPIN(xb_ld(&bar[XB_TOPGEN]) == tg, bar);
            __builtin_amdgcn_fence(__ATOMIC_ACQUIRE, "agent");
            xb_add(&bar[XB_XGEN(b.x)], 1u);
            asm volatile("s_waitcnt vmcnt(0)" ::: "memory");
        } else {
            XB_SPIN(xb_ld(&bar[XB_XGEN(b.x)]) == gen, bar);
            __builtin_amdgcn_fence(__ATOMIC_ACQUIRE, "agent");
            asm volatile("s_waitcnt vmcnt(0)" ::: "memory");
        }
    }
    __syncthreads();
}

constexpr int DM = 1024, M_TOT = 49152, M_G0 = 32768;
constexpr size_t MiB = 1u << 20, KiB = 1u << 10;
constexpr size_t WS_ROPE = 0;
constexpr size_t WS_STATS = 504 * MiB;
constexpr size_t WS_WS = 3 * MiB + 512 * KiB;
constexpr size_t WS_AIN = 4 * MiB, WS_QUP = 11 * MiB, WS_KVUP = 13 * MiB + 256 * KiB, WS_AOUT = 15 * MiB + 256 * KiB, WS_BIN = 19 * MiB + 256 * KiB, WS_BOUT = 43 * MiB + 256 * KiB;
constexpr size_t WS_H = 52 * MiB;
constexpr size_t WS_GATE = 148 * MiB, WS_QLAT = 244 * MiB, WS_KVLAT = 280 * MiB, WS_KROPE = 304 * MiB, WS_KV = 310 * MiB;
constexpr size_t WS_UG = 148 * MiB, WS_GV = 340 * MiB;
constexpr size_t WS_Q1 = 438 * MiB;
constexpr size_t WS_END = 486 * MiB;
constexpr int LDS_BYTES = 158720;

__device__ __forceinline__ unsigned f2bf(float f) { unsigned u = __builtin_bit_cast(unsigned, f); return (u + 0x7fffu + ((u >> 16) & 1u)) >> 16; }
__device__ __forceinline__ unsigned pk2(float lo, float hi) { return f2bf(lo) | (f2bf(hi) << 16); }
__device__ __forceinline__ float wave_sum(float v) {
#pragma unroll
    for (int o = 1; o < 64; o <<= 1) v += __shfl_xor(v, o);
    return v;
}
__device__ __forceinline__ int srccol(int mode, int n) {
    if (mode == 1) {
        if (n < 256) return 384 + n;
        if (n < 640) return n - 256;
        if (n < 704) { const int j = n - 640; return 640 + (j >> 1) + 32 * (j & 1); }
        if (n < 768) return -1;
        return 704 + (n - 768);
    }
    if (mode == 2) { const int h = n / 192, d = n % 192; if (d < 128) return n; const int j = d - 128; return h * 192 + 128 + (j >> 1) + 32 * (j & 1); }
    if (mode == 3) { if (n < 2048) return 2048 + n; const int t = (n - 2048) >> 8, r = (n - 2048) & 255; return r < 128 ? 128 * t + r : 4096 + 128 * t + (r - 128); }
    return n;
}
__device__ __forceinline__ void transpose_item(const float* W, int K, int N, int Nout, bf16* WT, LAS float* scr, int item, int lane, int mode, const float* kscale) {
    const int nblk = Nout / 32, kb = item / nblk, nb = item % nblk, k0 = 64 * kb, n0 = 32 * nb;
    const int src = srccol(mode, n0 + (lane & 31));
    float wv[32], ks[32];
#pragma unroll
    for (int i = 0; i < 32; ++i) { const int kk = 2 * i + (lane >> 5); wv[i] = (src >= 0) ? W[(size_t)(k0 + kk) * N + src] : 0.f; ks[i] = kscale ? kscale[k0 + kk] : 1.f; }
#pragma unroll
    for (int i = 0; i < 32; ++i) { const int kk = 2 * i + (lane >> 5); scr[kk * 33 + (lane & 31)] = wv[i] * ks[i]; }
    asm volatile("s_waitcnt lgkmcnt(0)" ::: "memory");
    const int c = lane & 7;
#pragma unroll
    for (int j = 0; j < 4; ++j) { const int n = (lane >> 3) + 8 * j; const LAS float* s = scr + (8 * c) * 33 + n;
        v4u o; o.x = pk2(s[0 * 33], s[1 * 33]); o.y = pk2(s[2 * 33], s[3 * 33]); o.z = pk2(s[4 * 33], s[5 * 33]); o.w = pk2(s[6 * 33], s[7 * 33]);
        *(v4u*)(WT + (size_t)(n0 + n) * K + k0 + 8 * c) = o; }
    asm volatile("s_waitcnt lgkmcnt(0)" ::: "memory");
}
template <bool FINAL>
__device__ __forceinline__ void rms_row(const float* xrow, const float* g, bf16* orow, float* frow, int lane, pg8::fx_t* ssq_out = nullptr) {
    const f32x4* xr = (const f32x4*)xrow + lane; const f32x4* gr = (const f32x4*)g + lane;
    f32x4 v[4]; float s = 0.f;
#pragma unroll
    for (int j = 0; j < 4; ++j) { v[j] = xr[64 * j]; s += (v[j].x * v[j].x + v[j].y * v[j].y) + (v[j].z * v[j].z + v[j].w * v[j].w); }
    const float tot = wave_sum(s); const float rstd = FINAL ? 1.0f / sqrtf(tot * (1.0f / 1024.0f) + 1e-6f) : 1.0f;
    if (!FINAL) { if (lane == 0) *ssq_out = (pg8::fx_t)(long long)(tot * 16777216.0f); }
#pragma unroll
    for (int j = 0; j < 4; ++j) { const f32x4 gg = FINAL ? gr[64 * j] : (f32x4){1.f, 1.f, 1.f, 1.f}; const f32x4 y = v[j] * rstd * gg;
        if (FINAL) ((f32x4*)frow + lane)[64 * j] = y;
        else { v2u w; w.x = pk2(y.x, y.y); w.y = pk2(y.z, y.w); ((v2u*)orow + lane)[64 * j] = w; } }
}
__device__ __forceinline__ void norm_phase(const float* x0, const float* x1  , const float* g, bf16* Hb, pg8::fx_t* ssq, int gw, int NGW, int lane) {
    int m = gw;
    for (; m + 3 * NGW < M_TOT; m += 4 * NGW) {
        f32x4 v[4][4];
#pragma unroll
        for (int r = 0; r < 4; ++r) { const int mm = m + r * NGW; const f32x4* xr = (const f32x4*)((mm < M_G0 ? x0 : x1) + (size_t)mm * DM) + lane;
#pragma unroll
            for (int j = 0; j < 4; ++j) v[r][j] = xr[64 * j]; }
#pragma unroll
        for (int r = 0; r < 4; ++r) { const int mm = m + r * NGW; float s = 0.f;
#pragma unroll
            for (int j = 0; j < 4; ++j) s += (v[r][j].x * v[r][j].x + v[r][j].y * v[r][j].y) + (v[r][j].z * v[r][j].z + v[r][j].w * v[r][j].w);
            const float tot = wave_sum(s); if (lane == 0) ssq[mm] = (pg8::fx_t)(long long)(tot * 16777216.0f);
#pragma unroll
            for (int j = 0; j < 4; ++j) { v2u w; w.x = pk2(v[r][j].x, v[r][j].y); w.y = pk2(v[r][j].z, v[r][j].w); ((v2u*)(Hb + (size_t)mm * DM) + lane)[64 * j] = w; } }
    }
    for (; m < M_TOT; m += NGW) rms_row<false>((m < M_G0 ? x0 : x1) + (size_t)m * DM, g, Hb + (size_t)m * DM, nullptr, lane, ssq + m);
}
__device__ __forceinline__ void spatial_unit(char* lds, const bf16* gvl  , const bf16* ugp  , bf16* outp, const pg8::fx_t* s1, const pg8::fx_t* s2  ,
                                              const bf16* wsg  , const float* lng, const float* lnb  , const float* bsg  , int g, int tid) {
    char* Wl = lds; char* VT = lds + 34816; float* mu = (float*)(lds + 34816 + 69632); float* rs = mu + 128;
    const int lane = tid & 63, wid = tid >> 6, r32 = lane & 31, hi = lane >> 5;
    if (tid < 128) { const float a = pg8::fx_get(s1 + tid) * (1.0f / 2048.0f), b = pg8::fx_get(s2 + tid) * (1.0f / 2048.0f); mu[tid] = a; rs[tid] = 1.0f / sqrtf(fmaxf(b - a * a, 0.f) + 1e-5f); }
#pragma unroll
    for (int i = 0; i < 4; ++i) { const int id = tid + 512 * i, p = id >> 4, qc = (id & 15) * 8; *(v4u*)(Wl + p * 272 + qc * 2) = *(const v4u*)(wsg + p * 128 + qc); }
    __syncthreads();
    {
        const int cc = (tid >> 3) & 31, c0 = 8 * cc;
        float lg[8], lb[8];
#pragma unroll
        for (int j = 0; j < 8; ++j) { lg[j] = lng[c0 + j]; lb[j] = lnb[c0 + j]; }
#pragma unroll
        for (int i = 0; i < 8; ++i) {
            const int q = (tid & 7) + 8 * ((tid >> 8) + 2 * i);
            const v4u raw = *(const v4u*)(gvl + (size_t)q * 2048 + g * 256 + c0);
            const float m_ = mu[q], r_ = rs[q];
            const unsigned wds[4] = {raw.x, raw.y, raw.z, raw.w};
#pragma unroll
            for (int j = 0; j < 8; ++j) { const unsigned wd = wds[j >> 1]; const float v = __uint_as_float((j & 1) ? (wd & 0xffff0000u) : (wd << 16));
                const float y = (v - m_) * r_ * lg[j] + lb[j]; const int c = c0 + j;
                *(bf16*)(VT + c * 272 + (((q >> 3) ^ ((c >> 3) & 7)) * 16) + (q & 7) * 2) = (bf16)f2bf(y); }
        }
    }
    __syncthreads();
    {
        const int c = 32 * wid + r32;
        bf16x8 a[8];
#pragma unroll
        for (int ks = 0; ks < 8; ++ks) a[ks] = *(const bf16x8*)(VT + c * 272 + (((2 * ks + hi) ^ ((c >> 3) & 7)) * 16));
        f32x16 acc[4];
#pragma unroll
        for (int pt = 0; pt < 4; ++pt) {
            acc[pt] = f32x16{};
            const int p = 32 * pt + r32;
#pragma unroll
            for (int ks = 0; ks < 8; ++ks) { const bf16x8 b = *(const bf16x8*)(Wl + p * 272 + (16 * ks + 8 * hi) * 2); acc[pt] = __builtin_amdgcn_mfma_f32_32x32x16_bf16(a[ks], b, acc[pt], 0, 0, 0); }
        }
        __syncthreads();
#pragma unroll
        for (int pt = 0; pt < 4; ++pt) {
            const int p = 32 * pt + r32; const float bias = bsg[p];
#pragma unroll
            for (int r4 = 0; r4 < 4; ++r4) { v2u w; w.x = pk2(acc[pt][4 * r4 + 0] + bias, acc[pt][4 * r4 + 1] + bias); w.y = pk2(acc[pt][4 * r4 + 2] + bias, acc[pt][4 * r4 + 3] + bias);
                *(v2u*)(VT + p * 528 + (32 * wid + 8 * r4 + 4 * hi) * 2) = w; }
        }
    }
    __syncthreads();
#pragma unroll
    for (int i = 0; i < 8; ++i) {
        const int id = tid + 512 * i, p = id >> 5, c0 = (id & 31) * 8; const size_t off = (size_t)p * 2048 + g * 256 + c0;
        const v4u sv = *(const v4u*)(VT + p * 528 + c0 * 2); const v4u uu = *(const v4u*)(ugp + off);
        v4u w;
        w.x = pk2(__uint_as_float(uu.x << 16) * __uint_as_float(sv.x << 16), __uint_as_float(uu.x & 0xffff0000u) * __uint_as_float(sv.x & 0xffff0000u));
        w.y = pk2(__uint_as_float(uu.y << 16) * __uint_as_float(sv.y << 16), __uint_as_float(uu.y & 0xffff0000u) * __uint_as_float(sv.y & 0xffff0000u));
        w.z = pk2(__uint_as_float(uu.z << 16) * __uint_as_float(sv.z << 16), __uint_as_float(uu.z & 0xffff0000u) * __uint_as_float(sv.z & 0xffff0000u));
        w.w = pk2(__uint_as_float(uu.w << 16) * __uint_as_float(sv.w << 16), __uint_as_float(uu.w & 0xffff0000u) * __uint_as_float(sv.w & 0xffff0000u));
        *(v4u*)(outp + off) = w;
    }
    __syncthreads();
}

__device__ __forceinline__ void spatial_phase(char* lds, const bf16* gv0, const bf16* gv1  , bf16* ug, const pg8::fx_t* s1, const pg8::fx_t* s2,
                                               const bf16* ws_l  , const float* lng_l, const float* lnb_l  , const float* bs_l  , int bid, int G, int tid) {
    char* Wl = lds; char* VT = lds + 34816; float* mu = (float*)(lds + 34816 + 69632); float* rs = mu + 128;
    const int lane = tid & 63, wid = tid >> 6, r32 = lane & 31, hi = lane >> 5;
    const int total = (M_TOT / 128) * 8;
    int ui = bid; if (ui >= total) return;
    const int cc = (tid >> 3) & 31, c0n = 8 * cc, q0 = (tid & 7) + 8 * (tid >> 8);
    v4u gvr[8], ugr[8]; float lg[8], lb[8]; int prev_gg = -1;
    const unsigned voffg = (unsigned)(q0 * 2048 + c0n) * 2u, voffu = (unsigned)((tid >> 5) * 2048 + (tid & 31) * 8) * 2u;
#define SP_GVP(u_) (((u_) >> 3) < M_G0 / 128 ? gv0 + (size_t)((u_) >> 3) * 128 * 2048 : gv1 + ((size_t)((u_) >> 3) * 128 - M_G0) * 2048)
#define SP_LOADGV(u_) do { const char* gp_ = (const char*)(SP_GVP(u_) + ((u_) & 7) * 256); _Pragma("unroll") for (int i = 0; i < 8; ++i) gvr[i] = *(const v4u*)(gp_ + (size_t)i * 65536 + voffg); } while (0)
    SP_LOADGV(ui);
    pg8::fx_t st1 = 0, st2 = 0;
    if (tid < 128) { st1 = s1[(size_t)(ui >> 3) * 128 + tid]; st2 = s2[(size_t)(ui >> 3) * 128 + tid]; }
    for (;;) {
        const int ch = ui >> 3, gg = ui & 7; const size_t grow = (size_t)ch * 128;
        if (tid < 128) { const float a = pg8::fx_get(&st1) * (1.0f / 2048.0f), b = pg8::fx_get(&st2) * (1.0f / 2048.0f); mu[tid] = a; rs[tid] = 1.0f / sqrtf(fmaxf(b - a * a, 0.f) + 1e-5f); }
        if (gg != prev_gg) {
            const bf16* wsg = ws_l + (size_t)gg * 128 * 128;
#pragma unroll
            for (int i = 0; i < 4; ++i) { const int id = tid + 512 * i, p = id >> 4, qc = (id & 15) * 8; *(v4u*)(Wl + p * 272 + qc * 2) = *(const v4u*)(wsg + p * 128 + qc); }
#pragma unroll
            for (int j = 0; j < 8; ++j) { lg[j] = lng_l[gg * 256 + c0n + j]; lb[j] = lnb_l[gg * 256 + c0n + j]; }
            prev_gg = gg;
        }
        __syncthreads();
#pragma unroll
        for (int i = 0; i < 8; ++i) {
            const int q = q0 + 16 * i; const v4u raw = gvr[i];
            const float m_ = mu[q], r_ = rs[q];
            const unsigned wds[4] = {raw.x, raw.y, raw.z, raw.w};
#pragma unroll
            for (int j = 0; j < 8; ++j) { const unsigned wd = wds[j >> 1]; const float v = __uint_as_float((j & 1) ? (wd & 0xffff0000u) : (wd << 16));
                const float y = (v - m_) * r_ * lg[j] + lb[j]; const int c = c0n + j;
                *(bf16*)(VT + c * 272 + (((q >> 3) ^ ((c >> 3) & 7)) * 16) + (q & 7) * 2) = (bf16)f2bf(y); }
        }
        const int nxt = ui + G;
        if (nxt < total) { SP_LOADGV(nxt); if (tid < 128) { st1 = s1[(size_t)(nxt >> 3) * 128 + tid]; st2 = s2[(size_t)(nxt >> 3) * 128 + tid]; } }
        bf16* ugp = ug + grow * 2048 + gg * 256;
        __syncthreads();
        {
            const int c = 32 * wid + r32;
            bf16x8 a[8];
#pragma unroll
            for (int ks = 0; ks < 8; ++ks) a[ks] = *(const bf16x8*)(VT + c * 272 + (((2 * ks + hi) ^ ((c >> 3) & 7)) * 16));
            f32x16 acc[4];
#pragma unroll
            for (int pt = 0; pt < 4; ++pt) {
                acc[pt] = f32x16{};
                const int p = 32 * pt + r32;
#pragma unroll
                for (int ks = 0; ks < 8; ++ks) { const bf16x8 b = *(const bf16x8*)(Wl + p * 272 + (16 * ks + 8 * hi) * 2); acc[pt] = __builtin_amdgcn_mfma_f32_32x32x16_bf16(a[ks], b, acc[pt], 0, 0, 0); }
            }
#pragma unroll
            for (int i = 0; i < 8; ++i) ugr[i] = *(const v4u*)((const char*)ugp + (size_t)i * 65536 + voffu);
            __syncthreads();
#pragma unroll
            for (int pt = 0; pt < 4; ++pt) {
                const int p = 32 * pt + r32; const float bias = bs_l[gg * 128 + p];
#pragma unroll
                for (int r4 = 0; r4 < 4; ++r4) { v2u w; w.x = pk2(acc[pt][4 * r4 + 0] + bias, acc[pt][4 * r4 + 1] + bias); w.y = pk2(acc[pt][4 * r4 + 2] + bias, acc[pt][4 * r4 + 3] + bias);
                    *(v2u*)(VT + p * 528 + (32 * wid + 8 * r4 + 4 * hi) * 2) = w; }
            }
        }
        __syncthreads();
#pragma unroll
        for (int i = 0; i < 8; ++i) {
            const int id = tid + 512 * i, p = id >> 5, c0 = (id & 31) * 8;
            const v4u sv = *(const v4u*)(VT + p * 528 + c0 * 2); const v4u uu = ugr[i];
            v4u w;
            w.x = pk2(__uint_as_float(uu.x << 16) * __uint_as_float(sv.x << 16), __uint_as_float(uu.x & 0xffff0000u) * __uint_as_float(sv.x & 0xffff0000u));
            w.y = pk2(__uint_as_float(uu.y << 16) * __uint_as_float(sv.y << 16), __uint_as_float(uu.y & 0xffff0000u) * __uint_as_float(sv.y & 0xffff0000u));
            w.z = pk2(__uint_as_float(uu.z << 16) * __uint_as_float(sv.z << 16), __uint_as_float(uu.z & 0xffff0000u) * __uint_as_float(sv.z & 0xffff0000u));
            w.w = pk2(__uint_as_float(uu.w << 16) * __uint_as_float(sv.w << 16), __uint_as_float(uu.w & 0xffff0000u) * __uint_as_float(sv.w & 0xffff0000u));
            *(v4u*)((char*)ugp + (size_t)i * 65536 + voffu) = w;
        }
        __syncthreads();
        if (nxt >= total) break;
        ui = nxt;
    }
#undef SP_GVP
#undef SP_LOADGV
}

#ifndef PROBE_SITE
#define PROBE_SITE (-1)
#endif
constexpr size_t WS_CTL = 500 * MiB, CTL_BYTES = 16384;
constexpr size_t WS_DUMMY = 468 * MiB;
struct Params {
    const float* xp; const float* xs; const float* norm_g; const float* final_g;
    const float* a_w_in; const float* a_q_norm; const float* a_kv_norm; const float* a_w_q_up; const float* a_w_kv_up; const float* a_w_out;
    const float* b_w_in; const float* b_ln_g; const float* b_ln_b; const float* b_w_s; const float* b_b_s; const float* b_w_out;
    float* out; unsigned char* ws; int ph_lo, ph_hi, probe, pad;
};

#define PARG(f) ({ const __attribute__((address_space(4))) Params* q_ = (const __attribute__((address_space(4))) Params*)__builtin_amdgcn_kernarg_segment_ptr(); asm volatile("" : "+s"(q_)); q_->f; })
#define WSP(off) (PARG(ws) + (off))
__global__ void __launch_bounds__(NTHR, 2) mk_fwd(Params Punused) {
    extern __shared__ __attribute__((aligned(16))) unsigned char lds[];
    cg::grid_group grid = cg::this_grid();
    const int wave = __builtin_amdgcn_readfirstlane((int)threadIdx.x >> 6);
#define MK_LANE() ({ int l_; asm volatile("v_mbcnt_lo_u32_b32 %0, -1, 0\n\tv_mbcnt_hi_u32_b32 %0, -1, %0" : "=v"(l_)); l_; })
    const int G = gridDim.x, bid = blockIdx.x;
    const int gw = bid * NWAVES + wave, NGW = G * NWAVES;
    const int lo = PARG(ph_lo), hi = PARG(ph_hi);
    int k = 0;
    { volatile LAS unsigned* misc = (volatile LAS unsigned*)((LAS unsigned char*)lds + LDS_MISC); if (threadIdx.x < 4) misc[threadIdx.x] = 0u; __syncthreads(); }
    const XcdBarrier xbar = xcd_barrier_post((unsigned*)WSP(WS_CTL), (volatile LAS unsigned*)((LAS unsigned char*)lds + LDS_MISC), threadIdx.x == 0);
    if (PARG(ph_hi) < 0) grid.sync();
    const int probe = PARG(probe);
#define REP(site) for (int rep = (probe == (site) ? 0 : 1); rep < 2; ++rep)
#define PH_ON (k >= lo && k < hi)
#define PH_NEXT do { ++k; if (k > lo && k < hi) { xcd_barrier(xbar, wave == 0 && MK_LANE() == 0); } } while (0)
#define ROPE ((f32x2*)WSP(WS_ROPE))
#define STATS ((pg8::fx_t*)WSP(WS_STATS))
#define H ((bf16*)WSP(WS_H))
#define XBA ((bf16*)PARG(out))
#define Qb ((bf16*)WSP(WS_H))
#define GATE ((bf16*)WSP(WS_GATE))
#define QLAT ((bf16*)WSP(WS_QLAT))
#define KVLAT ((bf16*)WSP(WS_KVLAT))
#define KROPE ((bf16*)WSP(WS_KROPE))
#define KVb ((bf16*)WSP(WS_KV))
#define Q_0 ((bf16*)WSP(WS_H))
#define Q_1 ((bf16*)WSP(WS_Q1))
#define KV_0 ((bf16*)WSP(WS_KV))
#define KV_1 ((bf16*)((unsigned char*)PARG(out) + 96 * MiB))
#define GV_0 ((bf16*)WSP(WS_GV))
#define GV_1 ((bf16*)((unsigned char*)PARG(out) + 96 * MiB))
#define UG ((bf16*)WSP(WS_UG))
#define GV ((bf16*)WSP(WS_GV))

    if (PH_ON) REP(0) {
        const int lane = MK_LANE(), tid = wave * 64 + lane;
        LAS float* scr = (LAS float*)((LAS unsigned char*)lds + wave * 16384);
        constexpr int I_AIN = 16 * 56, I_QUP = 6 * 48, I_KVUP = 4 * 64, I_AOUT = 16 * 32, I_BIN = 16 * 192, I_BOUT = 32 * 32;
        constexpr int I_LAYER = I_AIN + I_QUP + I_KVUP + I_AOUT + I_BIN + I_BOUT;
        for (int it = gw; it < 2 * I_LAYER; it += NGW) {
            const int j = it / I_LAYER; int r = it % I_LAYER;
            if (r < I_AIN) { transpose_item(PARG(a_w_in) + (size_t)j * 1024 * 1728, 1024, 1728, 1792, (bf16*)(WSP(0) + WS_AIN) + (size_t)j * 1792 * 1024, scr, r, lane, 1, PARG(norm_g) + (2 * j) * DM); continue; } r -= I_AIN;
            if (r < I_QUP) { transpose_item(PARG(a_w_q_up) + (size_t)j * 384 * 1536, 384, 1536, 1536, (bf16*)(WSP(0) + WS_QUP) + (size_t)j * 1536 * 384, scr, r, lane, 2, PARG(a_q_norm) + j * 384); continue; } r -= I_QUP;
            if (r < I_KVUP) { transpose_item(PARG(a_w_kv_up) + (size_t)j * 256 * 2048, 256, 2048, 2048, (bf16*)(WSP(0) + WS_KVUP) + (size_t)j * 2048 * 256, scr, r, lane, 0, PARG(a_kv_norm) + j * 256); continue; } r -= I_KVUP;
            if (r < I_AOUT) { transpose_item(PARG(a_w_out) + (size_t)j * 1024 * 1024, 1024, 1024, 1024, (bf16*)(WSP(0) + WS_AOUT) + (size_t)j * 1024 * 1024, scr, r, lane, 0, nullptr); continue; } r -= I_AOUT;
            if (r < I_BIN) { transpose_item(PARG(b_w_in) + (size_t)j * 1024 * 6144, 1024, 6144, 6144, (bf16*)(WSP(0) + WS_BIN) + (size_t)j * 6144 * 1024, scr, r, lane, 3, PARG(norm_g) + (2 * j + 1) * DM); continue; } r -= I_BIN;
            transpose_item(PARG(b_w_out) + (size_t)j * 2048 * 1024, 2048, 1024, 1024, (bf16*)(WSP(0) + WS_BOUT) + (size_t)j * 1024 * 2048, scr, r, lane, 0, nullptr);
        }
        const int gt = bid * NTHR + tid, NGT = G * NTHR;
        for (int i = gt; i < 2 * 8 * 128 * 128; i += NGT) ((bf16*)(WSP(0) + WS_WS))[i] = (bf16)f2bf(PARG(b_w_s)[i]);
        for (int i = gt; i < 11 * M_TOT; i += NGT) STATS[i + (i >= 8 * M_TOT ? M_TOT : 0)] = 0ull;
        for (int i = gt; i < 8192 * 32; i += NGT) {
            const int pos = i >> 5, ii = i & 31;
            const float inv = (float)exp2(-(double)ii * (13.287712379549449 / 32.0));
            const float ang = (float)pos * inv;
            const double t = (double)ang * 0.15915494309189535; const float fr = (float)(t - rint(t));
            ROPE[i] = (f32x2){__builtin_amdgcn_cosf(fr), __builtin_amdgcn_sinf(fr)};
        }
        norm_phase(PARG(xp), PARG(xs) - (size_t)M_G0 * DM, PARG(norm_g), XBA, STATS + (size_t)8 * M_TOT, gw, NGW, lane);
    }
    PH_NEXT;

#pragma nounroll
    for (int L = 0; L < 4; ++L) {
        const int j = L >> 1;
        if ((L & 1) == 0) {
            pg8::fx_t* ssq_q = STATS + (size_t)(0 + j) * M_TOT; pg8::fx_t* ssq_kv = STATS + (size_t)(2 + j) * M_TOT;
            if (PH_ON) {
                pg8::Gemm g{XBA, (const bf16*)(WSP(0) + WS_AIN) + (size_t)j * 1792 * 1024, M_TOT, 1792, 1024}; pg8::StaticOrder S; S.init(M_TOT, 1792, G, bid);
                pg8::EpiAIn E{QLAT, KVLAT, KROPE, GATE, ssq_q, ssq_kv, (const pg8::f32x2*)ROPE, STATS + (size_t)(8 + L) * M_TOT};
                pg8::gemm_phase<pg8::EpiAIn, pg8::StaticOrder, true, true>((LAS unsigned char*)lds, g, S, E, wave * 64 + MK_LANE());
            }
            PH_NEXT;
            if (PH_ON) {
                { pg8::Gemm g{QLAT, (const bf16*)(WSP(0) + WS_QUP) + (size_t)j * 1536 * 384, M_TOT, 1536, 384}; pg8::StaticOrder S; S.init(M_TOT, 1536, G, bid);
                  pg8::EpiQUp E{Q_0, Q_1 - (size_t)M_G0 * 1536, ssq_q, (const pg8::f32x2*)ROPE};
                  pg8::gemm_phase<pg8::EpiQUp, pg8::StaticOrder, true, false>((LAS unsigned char*)lds, g, S, E, wave * 64 + MK_LANE()); }
                { pg8::Gemm g{KVLAT, (const bf16*)(WSP(0) + WS_KVUP) + (size_t)j * 2048 * 256, M_TOT, 2048, 256}; pg8::StaticOrder S; S.init(M_TOT, 2048, G, bid);
                  pg8::EpiKvUp E{KV_0, KV_1 - (size_t)M_G0 * 2048, ssq_kv};
                  pg8::gemm_phase<pg8::EpiKvUp, pg8::StaticOrder, true, false>((LAS unsigned char*)lds, g, S, E, wave * 64 + MK_LANE()); }
            }
            PH_NEXT;
            if (PH_ON) {
#pragma nounroll
                for (int gi = 0; gi < 2; ++gi) {
                    const int grow0 = gi ? M_G0 : 0;
                    const int seq = gi ? 8192 : 4096, nb = gi ? 2 : 8, nqb = seq / 256, total = nb * 8 * nqb;
                    for (int i = 0; i * G + bid < total; ++i) {
                        int pair, qb;
                        if (G == 256) { const int xcd = bid & 7, slot = bid >> 3, ppx = (256 / nqb) / 8; pair = (i * 8 + xcd) * ppx + slot / nqb; qb = slot % nqb; }
                        else { const int ui = i * G + bid; pair = ui / nqb; qb = ui % nqb; }
                        const int b = pair >> 3, h = pair & 7; const size_t lrow_b = (size_t)b * seq, qrow_l = lrow_b + (size_t)qb * 256;
                        const bf16* Qg = gi ? Q_1 : Q_0; const bf16* KVg = gi ? KV_1 : KV_0;
                        __syncthreads();
                        att::attn_unit(Qg + qrow_l * 1536 + h * 192, KVg + lrow_b * 2048 + h * 256, KVg + lrow_b * 2048 + h * 256 + 128, KROPE + ((size_t)grow0 + lrow_b) * 64,
                                       GATE + ((size_t)grow0 + qrow_l) * 1024 + h * 128, seq, (char*)lds, wave * 64 + MK_LANE());
                    }
                }
            }
            PH_NEXT;
            if (PH_ON) {
                pg8::Gemm g{GATE, (const bf16*)(WSP(0) + WS_AOUT) + (size_t)j * 1024 * 1024, M_TOT, 1024, 1024}; pg8::StaticOrder S; S.init(M_TOT, 1024, G, bid);
                pg8::EpiResid E{XBA, H, (float*)nullptr, STATS + (size_t)(8 + L + 1) * M_TOT};
                pg8::gemm_phase<pg8::EpiResid, pg8::StaticOrder, true, true>((LAS unsigned char*)lds, g, S, E, wave * 64 + MK_LANE());
            }
            PH_NEXT;
        } else {
            pg8::fx_t* s1 = STATS + (size_t)(4 + j) * M_TOT; pg8::fx_t* s2 = STATS + (size_t)(6 + j) * M_TOT;
            if (PH_ON) {
                pg8::Gemm g{H, (const bf16*)(WSP(0) + WS_BIN) + (size_t)j * 6144 * 1024, M_TOT, 6144, 1024}; pg8::StaticOrder S; S.init(M_TOT, 6144, G, bid);
                pg8::EpiBIn E{GV_0, GV_1 - (size_t)M_G0 * 2048, UG, s1, s2, STATS + (size_t)(8 + L) * M_TOT};
                pg8::gemm_phase<pg8::EpiBIn, pg8::StaticOrder, true, true>((LAS unsigned char*)lds, g, S, E, wave * 64 + MK_LANE());
            }
            PH_NEXT;
            if (PH_ON) {
                spatial_phase((char*)lds, GV_0, GV_1, UG, s1, s2, (const bf16*)(WSP(0) + WS_WS) + (size_t)j * 8 * 128 * 128, PARG(b_ln_g) + j * 2048, PARG(b_ln_b) + j * 2048, PARG(b_b_s) + j * 8 * 128, bid, G, wave * 64 + MK_LANE());
            }
            PH_NEXT;
            if (PH_ON) REP(7) {
                pg8::Gemm g{UG, (const bf16*)(WSP(0) + WS_BOUT) + (size_t)j * 1024 * 2048, M_TOT, 1024, 2048}; pg8::StaticOrder S; S.init(M_TOT, 1024, G, bid);
                pg8::EpiResid E{H, XBA, L < 3 ? (float*)nullptr : PARG(out), rep ? STATS + (size_t)(8 + (L < 3 ? L + 1 : 0)) * M_TOT : (pg8::fx_t*)WSP(WS_DUMMY)};
                pg8::gemm_phase<pg8::EpiResid, pg8::StaticOrder, true, true>((LAS unsigned char*)lds, g, S, E, wave * 64 + MK_LANE());
            }
            PH_NEXT;
        }
    }
    if (PH_ON) {
        const int lane = MK_LANE();
        float* outp = PARG(out); const f32x4* gr = (const f32x4*)PARG(final_g) + lane;
        int m = gw;
        for (; m + 3 * NGW < M_TOT; m += 4 * NGW) {
            f32x4 v[4][4];
#pragma unroll
            for (int r = 0; r < 4; ++r) { const f32x4* xr = (const f32x4*)(outp + (size_t)(m + r * NGW) * DM) + lane;
#pragma unroll
                for (int jj = 0; jj < 4; ++jj) v[r][jj] = xr[64 * jj]; }
            f32x4 gg[4];
#pragma unroll
            for (int jj = 0; jj < 4; ++jj) gg[jj] = gr[64 * jj];
#pragma unroll
            for (int r = 0; r < 4; ++r) { float s_ = 0.f;
#pragma unroll
                for (int jj = 0; jj < 4; ++jj) s_ += (v[r][jj].x * v[r][jj].x + v[r][jj].y * v[r][jj].y) + (v[r][jj].z * v[r][jj].z + v[r][jj].w * v[r][jj].w);
                const float rstd = 1.0f / sqrtf(wave_sum(s_) * (1.0f / 1024.0f) + 1e-6f);
                f32x4* orow = (f32x4*)(outp + (size_t)(m + r * NGW) * DM) + lane;
#pragma unroll
                for (int jj = 0; jj < 4; ++jj) orow[64 * jj] = v[r][jj] * rstd * gg[jj]; }
        }
        for (; m < M_TOT; m += NGW) rms_row<true>(outp + (size_t)m * DM, PARG(final_g), nullptr, outp + (size_t)m * DM, lane);
    }
}

extern "C" void kernel_launch(void* const* d_in, const int* in_sizes, int n_in, void* d_out, int out_size, void* d_ws, size_t ws_size, hipStream_t stream) {
    static int grid = 0;
    if (grid == 0) {
        if (n_in != 16 || out_size != M_TOT * DM || ws_size < 509 * MiB) { fprintf(stderr, "kernel_launch: unexpected shapes: n_in %d out %d ws %zu (need >= %zu)\n", n_in, out_size, ws_size, (size_t)WS_END); grid = -1; return; }
        int dev = 0, cus = 0, per_cu = 0;
        hipGetDevice(&dev); hipDeviceGetAttribute(&cus, hipDeviceAttributeMultiprocessorCount, dev);
        if (hipFuncSetAttribute((const void*)mk_fwd, hipFuncAttributeMaxDynamicSharedMemorySize, LDS_BYTES) != hipSuccess) { fprintf(stderr, "kernel_launch: hipFuncSetAttribute failed\n"); grid = -1; return; }
        if (hipOccupancyMaxActiveBlocksPerMultiprocessor(&per_cu, (const void*)mk_fwd, NTHR, LDS_BYTES) != hipSuccess || per_cu < 1) { fprintf(stderr, "kernel_launch: occupancy query gave %d\n", per_cu); per_cu = 1; }
        (void)hipGetLastError();
        grid = cus;
        fprintf(stderr, "kernel_launch: cus %d per_cu %d grid %d\n", cus, per_cu, grid);
    }
    if (grid < 0) return;
    if (hipMemsetAsync((char*)d_ws + WS_CTL, 0, CTL_BYTES, stream) != hipSuccess) { fprintf(stderr, "kernel_launch: memset failed\n"); return; }
    Params p{};
    p.xp = (const float*)d_in[0]; p.xs = (const float*)d_in[1]; p.norm_g = (const float*)d_in[2]; p.final_g = (const float*)d_in[3];
    p.a_w_in = (const float*)d_in[4]; p.a_q_norm = (const float*)d_in[5]; p.a_kv_norm = (const float*)d_in[6]; p.a_w_q_up = (const float*)d_in[7]; p.a_w_kv_up = (const float*)d_in[8]; p.a_w_out = (const float*)d_in[9];
    p.b_w_in = (const float*)d_in[10]; p.b_ln_g = (const float*)d_in[11]; p.b_ln_b = (const float*)d_in[12]; p.b_w_s = (const float*)d_in[13]; p.b_b_s = (const float*)d_in[14]; p.b_w_out = (const float*)d_in[15];
    p.out = (float*)d_out; p.ws = (unsigned char*)d_ws; p.ph_lo = 0; p.ph_hi = 1000; p.probe = PROBE_SITE;
    void* args[] = {&p};
    const hipError_t e = hipLaunchCooperativeKernel((const void*)mk_fwd, dim3(grid), dim3(NTHR), args, LDS_BYTES, stream);
    if (e != hipSuccess) fprintf(stderr, "kernel_launch: cooperative launch failed: %s (grid %d)\n", hipGetErrorString(e), grid);
}
```

```cpp
#include <hip/hip_runtime.h>
#include <hip/hip_cooperative_groups.h>
#include <hip/hip_bf16.h>
#include <cstdio>
#include <cstdint>
namespace cg = cooperative_groups;
namespace pg8 {
#define PG8_LAS __attribute__((address_space(3)))
typedef unsigned short bf16_t;
typedef short bf16x8 __attribute__((ext_vector_type(8)));
typedef float f32x4 __attribute__((ext_vector_type(4)));
typedef unsigned u32x4 __attribute__((ext_vector_type(4)));
constexpr int BM = 256, BK = 64, HALF = 128, HTB = HALF * BK * 2  , STAGE_BYTES = 8 * HTB, NXCD = 8, WGM = 8;

__host__ __device__ __forceinline__ int lds_byte(int r, int c) { const int st = (r >> 4) * 2 + (c >> 5), rr = r & 15, cc = c & 31, ob = rr * 64 + cc * 2; return st * 1024 + (ob ^ (((ob >> 9) & 1) << 5)); }
__host__ __device__ __forceinline__ void stage_rc(int b, int& R, int& C) { const int st = b / 1024, sb = b % 1024, swz = sb ^ (((sb >> 9) & 1) << 5); R = (st >> 1) * 16 + swz / 64; C = (st & 1) * 32 + (swz % 64) / 2; }
__host__ __device__ __forceinline__ int perm32(int rho) { const int n = rho >> 4, i = rho & 15; return 8 * (i >> 2) + 4 * n + (i & 3); }

struct Unit { int pm, pn; };
struct Gemm { const bf16_t* A; const bf16_t* Bt; int M, N, K; };

struct StaticOrder {
    int nM, nN, nwg, G, c;
    __host__ __device__ void init(int M, int N, int G_, int c_) { nM = M / BM; nN = N / BM; nwg = nM * nN; G = G_; c = c_; }
    __host__ __device__ bool next(int i, Unit& u) const {
        const long L = (long)i * G + c; if (L >= nwg) return false;
        int wgid = (int)L; { const int q = nwg / NXCD, r = nwg % NXCD, xcd = wgid % NXCD, off = wgid / NXCD; wgid = (xcd < r ? xcd * (q + 1) : r * (q + 1) + (xcd - r) * q) + off; }
        const int nig = WGM * nN, gid = wgid / nig, fm = gid * WGM, gsz = (nM - fm) < WGM ? (nM - fm) : WGM;
        u.pm = fm + ((wgid % nig) % gsz); u.pn = (wgid % nig) / gsz; return true;
    }
    __device__ __forceinline__ void a_ready(const Unit&) const {}
    __device__ __forceinline__ void done(const Unit&) const {}
};

__device__ __forceinline__ unsigned cvt_pk_bf16(float lo, float hi) { unsigned r; asm volatile("v_cvt_pk_bf16_f32 %0, %1, %2" : "=v"(r) : "v"(lo), "v"(hi)); return r; }
typedef float f32x2 __attribute__((ext_vector_type(2)));
__device__ __forceinline__ f32x2 gelu_pk(f32x2 v) {
    const f32x2 av = __builtin_elementwise_abs(v), d = av * 0.2316418882f + 1.0f;
    f32x2 t; t.x = __builtin_amdgcn_rcpf(d.x); t.y = __builtin_amdgcn_rcpf(d.y);
    f32x2 q = t * 0.5307027145f + (-0.7265760135f); q = q * t + 0.7107068705f; q = q * t + (-0.142248368f); q = q * t + 0.127414796f; q = q * t;
    const f32x2 s = (v * v) * (-0.72134752044f);
    f32x2 e; e.x = __builtin_amdgcn_exp2f(s.x); e.y = __builtin_amdgcn_exp2f(s.y);
    const f32x2 m = v * (q * e), r = v - m;
    f32x2 o; o.x = v.x < 0.f ? m.x : r.x; o.y = v.y < 0.f ? m.y : r.y; return o;
}
typedef float f32x2 __attribute__((ext_vector_type(2)));
__device__ __forceinline__ float silu_f(float x) { return x * __builtin_amdgcn_rcpf(1.0f + __builtin_amdgcn_exp2f(-1.4426950408889634f * x)); }
__device__ __forceinline__ float bf2f(unsigned short b) { return __uint_as_float(((unsigned)b) << 16); }
__device__ __forceinline__ int tok_pos(int row) { return row < 32768 ? (row & 4095) : (row & 8191); }
__device__ __forceinline__ void store8(bf16_t* p, const f32x4 a, const f32x4 b) {
    u32x4 w; w.x = cvt_pk_bf16(a[0], a[1]); w.y = cvt_pk_bf16(a[2], a[3]); w.z = cvt_pk_bf16(b[0], b[1]); w.w = cvt_pk_bf16(b[2], b[3]); *(u32x4*)p = w; }
__device__ __forceinline__ void rope8(f32x4& a, f32x4& b, const f32x2* tab  ) {
    const f32x2 t0 = tab[0], t1 = tab[1], t2 = tab[2], t3 = tab[3];
    f32x4 oa, ob;
    oa[0] = a[0] * t0.x - a[1] * t0.y; oa[1] = a[1] * t0.x + a[0] * t0.y;
    oa[2] = a[2] * t1.x - a[3] * t1.y; oa[3] = a[3] * t1.x + a[2] * t1.y;
    ob[0] = b[0] * t2.x - b[1] * t2.y; ob[1] = b[1] * t2.x + b[0] * t2.y;
    ob[2] = b[2] * t3.x - b[3] * t3.y; ob[3] = b[3] * t3.x + b[2] * t3.y;
    a = oa; b = ob;
}
typedef unsigned long long fx_t;
__device__ __forceinline__ void fx_add(fx_t* p, float v) { atomicAdd(p, (fx_t)(long long)(v * 16777216.0f)); }
__device__ __forceinline__ float fx_get(const fx_t* p) { const fx_t v = *p; return (float)(int)(v >> 32) * 256.0f + (float)(unsigned)v * 5.9604644775390625e-8f; }
__device__ __forceinline__ float sq4(const f32x4 v) { return (v[0] * v[0] + v[1] * v[1]) + (v[2] * v[2] + v[3] * v[3]); }
__device__ __forceinline__ float sum4(const f32x4 v) { return (v[0] + v[1]) + (v[2] + v[3]); }

struct EpiAIn {
    static constexpr bool PERM = true, AFTER_DRAIN = false;
    bf16_t* qlat; bf16_t* kvlat; bf16_t* krope; bf16_t* gate; fx_t* ssq_q; fx_t* ssq_kv; const f32x2* rope; const fx_t* ssq_x;
    __device__ __forceinline__ void operator()(const f32x4 (&acc)[2][2][4][2], const Unit& u, int wr, int wc, int fr, int fq) const {
        const int pn = u.pn, cw = wc * 32 + 8 * fq, row0 = u.pm * BM + wr * 64 + fr;
        float rsx[2][4];
#pragma unroll
        for (int ai = 0; ai < 2; ++ai)
#pragma unroll
            for (int m = 0; m < 4; ++m) rsx[ai][m] = fx_get(ssq_x + row0 + ai * HALF + m * 16);
#pragma unroll
        for (int ai = 0; ai < 2; ++ai)
#pragma unroll
            for (int m = 0; m < 4; ++m) rsx[ai][m] = __builtin_amdgcn_rsqf(rsx[ai][m] * (1.0f / 1024.0f) + 1e-6f);
        const bool do_rope = (pn == 2) && (wc < 2);
#pragma unroll
        for (int ai = 0; ai < 2; ++ai) {
            f32x2 rp[4][4];
            if (do_rope) {
#pragma unroll
                for (int m = 0; m < 4; ++m) { const f32x2* t = rope + (size_t)tok_pos(row0 + ai * HALF + m * 16) * 32 + (cw >> 1);
#pragma unroll
                    for (int k = 0; k < 4; ++k) rp[m][k] = t[k]; }
            }
#pragma unroll
            for (int m = 0; m < 4; ++m) {
                const int row = row0 + ai * HALF + m * 16;
                const float rs_ = rsx[ai][m];
                if (pn <= 1) {
                    bf16_t* dst = (pn == 0) ? (kvlat + (size_t)row * 256) : (qlat + (size_t)row * 384);
                    float ss = 0.f;
#pragma unroll
                    for (int bj = 0; bj < 2; ++bj) { const f32x4 a = acc[ai][bj][m][0] * rs_, b = acc[ai][bj][m][1] * rs_; ss += sq4(a) + sq4(b); store8(dst + bj * HALF + cw, a, b); }
                    ss += __shfl_xor(ss, 16); ss += __shfl_xor(ss, 32);
                    if (fq == 0) fx_add((pn == 0 ? ssq_kv : ssq_q) + row, ss);
                } else if (pn == 2) {
                    { const f32x4 a = acc[ai][0][m][0] * rs_, b = acc[ai][0][m][1] * rs_; float ss = sq4(a) + sq4(b); store8(qlat + (size_t)row * 384 + 256 + cw, a, b);
                      ss += __shfl_xor(ss, 16); ss += __shfl_xor(ss, 32); if (fq == 0) fx_add(ssq_q + row, ss); }
                    if (do_rope) { f32x4 a = acc[ai][1][m][0] * rs_, b = acc[ai][1][m][1] * rs_; rope8(a, b, rp[m]); store8(krope + (size_t)row * 64 + cw, a, b); }
                } else {
#pragma unroll
                    for (int bj = 0; bj < 2; ++bj) { f32x4 a = acc[ai][bj][m][0] * rs_, b = acc[ai][bj][m][1] * rs_;
#pragma unroll
                        for (int j = 0; j < 4; ++j) { a[j] = silu_f(a[j]); b[j] = silu_f(b[j]); }
                        store8(gate + (size_t)row * 1024 + (pn - 3) * 256 + bj * HALF + cw, a, b); }
                }
            }
        }
    }
};
struct EpiQUp {
    static constexpr bool PERM = true, AFTER_DRAIN = false;
    bf16_t* Q0; bf16_t* Q1; const fx_t* ssq_q; const f32x2* rope;
    __device__ __forceinline__ void operator()(const f32x4 (&acc)[2][2][4][2], const Unit& u, int wr, int wc, int fr, int fq) const {
        { int l_; asm volatile("v_mbcnt_lo_u32_b32 %0, -1, 0\n\tv_mbcnt_hi_u32_b32 %0, -1, %0" : "=v"(l_)); fr = l_ & 15; fq = l_ >> 4; }
        const int row0 = u.pm * BM + wr * 64 + fr; bf16_t* Q = (u.pm < 128) ? Q0 : Q1;
        float rstd[2][4];
#pragma unroll
        for (int ai = 0; ai < 2; ++ai)
#pragma unroll
            for (int m = 0; m < 4; ++m) rstd[ai][m] = fx_get(ssq_q + row0 + ai * HALF + m * 16);
#pragma unroll
        for (int ai = 0; ai < 2; ++ai)
#pragma unroll
            for (int m = 0; m < 4; ++m) rstd[ai][m] = __builtin_amdgcn_rsqf(rstd[ai][m] * (1.0f / 384.0f) + 1e-6f);
#pragma unroll
        for (int bj = 0; bj < 2; ++bj) {
            const int c0 = u.pn * BM + bj * HALF + wc * 32 + 8 * fq, d = c0 % 192;
#pragma unroll
            for (int ai = 0; ai < 2; ++ai) {
                f32x2 rp[4][4];
                if (d >= 128) {
#pragma unroll
                    for (int m = 0; m < 4; ++m) { const f32x2* t = rope + (size_t)tok_pos(row0 + ai * HALF + m * 16) * 32 + ((d - 128) >> 1);
#pragma unroll
                        for (int k = 0; k < 4; ++k) rp[m][k] = t[k]; }
                }
#pragma unroll
                for (int m = 0; m < 4; ++m) {
                    const int row = row0 + ai * HALF + m * 16;
                    f32x4 a = acc[ai][bj][m][0] * rstd[ai][m], b = acc[ai][bj][m][1] * rstd[ai][m];
                    if (d >= 128) rope8(a, b, rp[m]);
                    store8(Q + (size_t)row * 1536 + c0, a, b);
                }
            }
        }
    }
};
struct EpiKvUp {
    static constexpr bool PERM = true, AFTER_DRAIN = false;
    bf16_t* KV0; bf16_t* KV1; const fx_t* ssq_kv;
    __device__ __forceinline__ void operator()(const f32x4 (&acc)[2][2][4][2], const Unit& u, int wr, int wc, int fr, int fq) const {
        const int row0 = u.pm * BM + wr * 64 + fr; bf16_t* KV = (u.pm < 128) ? KV0 : KV1;
        float rstd[2][4];
#pragma unroll
        for (int ai = 0; ai < 2; ++ai)
#pragma unroll
            for (int m = 0; m < 4; ++m) rstd[ai][m] = fx_get(ssq_kv + row0 + ai * HALF + m * 16);
#pragma unroll
        for (int ai = 0; ai < 2; ++ai)
#pragma unroll
            for (int m = 0; m < 4; ++m) {
                const int row = row0 + ai * HALF + m * 16;
                const float r_ = __builtin_amdgcn_rsqf(rstd[ai][m] * (1.0f / 256.0f) + 1e-6f);
#pragma unroll
                for (int bj = 0; bj < 2; ++bj) {
                    const int c0 = u.pn * BM + bj * HALF + wc * 32 + 8 * fq;
                    store8(KV + (size_t)row * 2048 + c0, acc[ai][bj][m][0] * r_, acc[ai][bj][m][1] * r_);
                }
            }
    }
};
struct EpiResid {
    static constexpr bool PERM = true, AFTER_DRAIN = false;
    const bf16_t* Xin; bf16_t* Xout; float* outf; fx_t* ssqn;
    __device__ __forceinline__ void operator()(const f32x4 (&acc)[2][2][4][2], const Unit& u, int wr, int wc, int fr, int fq) const {
        const int col = u.pn * BM + wc * 32 + 8 * fq, row0 = u.pm * BM + wr * 64 + fr;
        u32x4 xr[2][4][2];
#pragma unroll
        for (int ai = 0; ai < 2; ++ai)
#pragma unroll
            for (int m = 0; m < 4; ++m)
#pragma unroll
                for (int bj = 0; bj < 2; ++bj) xr[ai][m][bj] = *(const u32x4*)(Xin + (size_t)(row0 + ai * HALF + m * 16) * 1024 + col + bj * HALF);
#pragma unroll
        for (int ai = 0; ai < 2; ++ai)
#pragma unroll
            for (int m = 0; m < 4; ++m) {
                const int row = row0 + ai * HALF + m * 16;
                const size_t off = (size_t)row * 1024 + col;
                float ss = 0.f;
#pragma unroll
                for (int bj = 0; bj < 2; ++bj) {
                    const u32x4 xb = xr[ai][m][bj];
                    const f32x4 x0 = {__uint_as_float(xb.x << 16), __uint_as_float(xb.x & 0xffff0000u), __uint_as_float(xb.y << 16), __uint_as_float(xb.y & 0xffff0000u)};
                    const f32x4 x1 = {__uint_as_float(xb.z << 16), __uint_as_float(xb.z & 0xffff0000u), __uint_as_float(xb.w << 16), __uint_as_float(xb.w & 0xffff0000u)};
                    const f32x4 y0 = x0 + acc[ai][bj][m][0], y1 = x1 + acc[ai][bj][m][1];
                    if (outf) { *(f32x4*)(outf + off + bj * HALF) = y0; *(f32x4*)(outf + off + bj * HALF + 4) = y1; }
                    else { ss += sq4(y0) + sq4(y1); store8(Xout + off + bj * HALF, y0, y1); }
                }
                if (!outf) { ss += __shfl_xor(ss, 16); ss += __shfl_xor(ss, 32); if (fq == 0) fx_add(ssqn + row, ss); }
            }
    }
};
struct EpiBIn {
    static constexpr bool PERM = true, AFTER_DRAIN = false;
    bf16_t* gv0; bf16_t* gv1; bf16_t* ug; fx_t* s1; fx_t* s2; const fx_t* ssq_x;
    __device__ __forceinline__ void operator()(const f32x4 (&acc)[2][2][4][2], const Unit& u, int wr, int wc, int fr, int fq) const {
        const int pn = u.pn, cw = wc * 32 + 8 * fq, row0 = u.pm * BM + wr * 64 + fr;
        float rsx_[2][4];
#pragma unroll
        for (int ai = 0; ai < 2; ++ai)
#pragma unroll
            for (int m = 0; m < 4; ++m) rsx_[ai][m] = fx_get(ssq_x + row0 + ai * HALF + m * 16);
#pragma unroll
        for (int ai = 0; ai < 2; ++ai)
#pragma unroll
            for (int m = 0; m < 4; ++m) {
                const int row = row0 + ai * HALF + m * 16; bf16_t* gv = (u.pm < 128) ? gv0 : gv1;
                const float rsx = __builtin_amdgcn_rsqf(rsx_[ai][m] * (1.0f / 1024.0f) + 1e-6f);
                if (pn < 8) {
                    float a1 = 0.f, a2 = 0.f;
#pragma unroll
                    for (int bj = 0; bj < 2; ++bj) { f32x4 a = acc[ai][bj][m][0] * rsx, b = acc[ai][bj][m][1] * rsx;
                        const f32x2 g0 = gelu_pk((f32x2){a[0], a[1]}), g1 = gelu_pk((f32x2){a[2], a[3]}), g2 = gelu_pk((f32x2){b[0], b[1]}), g3 = gelu_pk((f32x2){b[2], b[3]});
                        a = (f32x4){g0.x, g0.y, g1.x, g1.y}; b = (f32x4){g2.x, g2.y, g3.x, g3.y};
                        a1 += sum4(a) + sum4(b); a2 += sq4(a) + sq4(b);
                        store8(gv + (size_t)row * 2048 + pn * 256 + bj * HALF + cw, a, b); }
                    a1 += __shfl_xor(a1, 16); a1 += __shfl_xor(a1, 32); a2 += __shfl_xor(a2, 16); a2 += __shfl_xor(a2, 32);
                    if (fq == 0) { fx_add(s1 + row, a1); fx_add(s2 + row, a2); }
                } else {
                    f32x4 a = acc[ai][0][m][0] * rsx, b = acc[ai][0][m][1] * rsx; const f32x4 ga = acc[ai][1][m][0] * rsx, gb = acc[ai][1][m][1] * rsx;
                    const f32x2 g0 = gelu_pk((f32x2){a[0], a[1]}), g1 = gelu_pk((f32x2){a[2], a[3]}), g2 = gelu_pk((f32x2){b[0], b[1]}), g3 = gelu_pk((f32x2){b[2], b[3]});
                    a = (f32x4){g0.x * silu_f(ga[0]), g0.y * silu_f(ga[1]), g1.x * silu_f(ga[2]), g1.y * silu_f(ga[3])};
                    b = (f32x4){g2.x * silu_f(gb[0]), g2.y * silu_f(gb[1]), g3.x * silu_f(gb[2]), g3.y * silu_f(gb[3])};
                    store8(ug + (size_t)row * 2048 + (pn - 8) * 128 + cw, a, b);
                }
            }
    }
};
template <class Epi, class Sched, bool ALIGN_EPI = false, bool SP2 = false>
__device__ __forceinline__ void gemm_phase(PG8_LAS unsigned char* lds, const Gemm g, const Sched& S, const Epi& E, const int tid) {
    const int wid = __builtin_amdgcn_readfirstlane(tid >> 6), lane = tid & 63, wr = wid >> 2, wc = wid & 3, fr = lane & 15, fq = lane >> 4;
    const int K = g.K, nt = K / BK;
    unsigned voffA[2], voffB[2];
#pragma unroll
    for (int i = 0; i < 2; ++i) { int R, C; stage_rc(tid * 16 + i * 8192, R, C); const int Rb = Epi::PERM ? ((R & ~31) + perm32(R & 31)) : R;
        voffA[i] = (unsigned)(R * K + C) * 2u; voffB[i] = (unsigned)(Rb * K + C) * 2u; }
    const size_t kstep = (size_t)(BK * 2);
    const size_t hstep = (size_t)HALF * K * 2;
    const size_t tstep = 2 * hstep;
    const unsigned ldsw = (unsigned)wid * 1024u;
    const int aoff = lds_byte(wr * 64 + fr, fq * 8), boff = lds_byte(wc * 32 + fr, fq * 8);
#define PG8_SA(b, h) (((b) * 2 + (h)) * HTB)
#define PG8_SB(b, h) ((4 + (b) * 2 + (h)) * HTB)
#define PG8_STAGE(bufoff, gbase, voff) do { _Pragma("unroll") for (int _i = 0; _i < 2; ++_i) \
        __builtin_amdgcn_global_load_lds((const unsigned*)((const char*)(gbase) + (voff)[_i]), (PG8_LAS unsigned*)(lds + (bufoff) + ldsw + _i * 8192), 16, 0, 0); } while (0)
#define PG8_LDA(dst, b, h) do { _Pragma("unroll") for (int m = 0; m < 4; ++m) _Pragma("unroll") for (int k = 0; k < 2; ++k) dst[m][k] = *(const PG8_LAS bf16x8*)(lds + PG8_SA(b, h) + aoff + m * 2048 + k * 1024); } while (0)
#define PG8_LDB(dst, b, h) do { _Pragma("unroll") for (int n = 0; n < 2; ++n) _Pragma("unroll") for (int k = 0; k < 2; ++k) dst[n][k] = *(const PG8_LAS bf16x8*)(lds + PG8_SB(b, h) + boff + n * 2048 + k * 1024); } while (0)
#define PG8_MMA(ai, bj, At, Bt) do { __builtin_amdgcn_s_setprio(1); _Pragma("unroll") for (int m = 0; m < 4; ++m) _Pragma("unroll") for (int n = 0; n < 2; ++n) _Pragma("unroll") for (int k = 0; k < 2; ++k) \
        acc[ai][bj][m][n] = __builtin_amdgcn_mfma_f32_16x16x32_bf16(Bt[n][k], At[m][k], acc[ai][bj][m][n], 0, 0, 0); __builtin_amdgcn_s_setprio(0); } while (0)
#define PG8_WAIT_V(n) asm volatile("s_waitcnt vmcnt(" #n ")" ::: "memory")
#define PG8_WAIT_L(n) asm volatile("s_waitcnt lgkmcnt(" #n ")" ::: "memory")
#define PG8_BAR __builtin_amdgcn_s_barrier()
#define PG8_SCHED __builtin_amdgcn_sched_barrier(0)
    Unit cur, nxt; int ui = 0;
    if (!S.next(0, cur)) return;
    f32x4 acc[2][2][4][2];
#pragma unroll
    for (int a = 0; a < 2; ++a)
#pragma unroll
        for (int b = 0; b < 2; ++b)
#pragma unroll
            for (int m = 0; m < 4; ++m)
#pragma unroll
                for (int n = 0; n < 2; ++n) acc[a][b][m][n] = (f32x4){0.f, 0.f, 0.f, 0.f};
    bf16x8 At[4][2], B0[2][2], B1[2][2];
    const char* cA = (const char*)g.A + (size_t)cur.pm * tstep; const char* cB = (const char*)g.Bt + (size_t)cur.pn * tstep;
    S.a_ready(cur);
    if constexpr (SP2) {
        PG8_STAGE(PG8_SB(0, 0), cB, voffB); PG8_STAGE(PG8_SB(0, 1), cB + hstep, voffB); PG8_STAGE(PG8_SA(0, 0), cA, voffA); PG8_STAGE(PG8_SA(0, 1), cA + hstep, voffA);
        if (wr == 1) PG8_BAR;
        PG8_WAIT_V(2); PG8_BAR;
        PG8_STAGE(PG8_SB(1, 0), cB + kstep, voffB); PG8_STAGE(PG8_SA(1, 0), cA + kstep, voffA); PG8_STAGE(PG8_SB(1, 1), cB + hstep + kstep, voffB);
        PG8_WAIT_V(6); PG8_BAR;
    } else {
        PG8_STAGE(PG8_SB(0, 0), cB, voffB); PG8_STAGE(PG8_SA(0, 0), cA, voffA); PG8_STAGE(PG8_SB(0, 1), cB + hstep, voffB); PG8_STAGE(PG8_SA(0, 1), cA + hstep, voffA);
        if (wr == 1) PG8_BAR;
        PG8_WAIT_V(4); PG8_BAR;
        PG8_STAGE(PG8_SB(1, 0), cB + kstep, voffB); PG8_STAGE(PG8_SA(1, 0), cA + kstep, voffA); PG8_STAGE(PG8_SB(1, 1), cB + hstep + kstep, voffB);
        PG8_WAIT_V(6); PG8_BAR;
    }
    for (;;) {
        const bool has_next = S.next(ui + 1, nxt);
        const char* nA = has_next ? (const char*)g.A + (size_t)nxt.pm * tstep : cA; const char* nB = has_next ? (const char*)g.Bt + (size_t)nxt.pn * tstep : cB;
        for (int t = 0; t < nt; t += 2) {
            const bool last = (t == nt - 2);
            const char* a1 = cA + (size_t)(t + 1) * kstep;
            const char* a2 = last ? nA : cA + (size_t)(t + 2) * kstep; const char* b2 = last ? nB : cB + (size_t)(t + 2) * kstep;
            const char* a3 = a2 + kstep; const char* b3 = b2 + kstep;
            if (last && has_next) S.a_ready(nxt);
            if constexpr (SP2) {
            PG8_LDB(B0, 0, 0); PG8_LDB(B1, 0, 1); PG8_SCHED; PG8_LDA(At, 0, 0); PG8_STAGE(PG8_SA(1, 1), a1 + hstep, voffA);
            PG8_WAIT_V(8); PG8_WAIT_L(0); PG8_BAR; PG8_MMA(0, 0, At, B0); PG8_MMA(0, 1, At, B1); PG8_BAR; PG8_SCHED;
            PG8_LDA(At, 0, 1); PG8_STAGE(PG8_SB(0, 0), b2, voffB); PG8_STAGE(PG8_SB(0, 1), b2 + hstep, voffB); PG8_STAGE(PG8_SA(0, 0), a2, voffA);
            PG8_WAIT_V(8); PG8_WAIT_L(0); PG8_BAR; PG8_MMA(1, 0, At, B0); PG8_MMA(1, 1, At, B1); PG8_BAR; PG8_SCHED;
            PG8_LDB(B0, 1, 0); PG8_LDB(B1, 1, 1); PG8_SCHED; PG8_LDA(At, 1, 0); PG8_STAGE(PG8_SA(0, 1), a2 + hstep, voffA);
            PG8_WAIT_V(8); PG8_WAIT_L(0); PG8_BAR; PG8_MMA(0, 0, At, B0); PG8_MMA(0, 1, At, B1); PG8_BAR; PG8_SCHED;
            PG8_LDA(At, 1, 1); PG8_STAGE(PG8_SB(1, 0), b3, voffB); PG8_STAGE(PG8_SB(1, 1), b3 + hstep, voffB); PG8_STAGE(PG8_SA(1, 0), a3, voffA);
            PG8_WAIT_V(8); PG8_WAIT_L(0); PG8_BAR; PG8_MMA(1, 0, At, B0); PG8_MMA(1, 1, At, B1); PG8_BAR; PG8_SCHED;
            } else {
            PG8_LDB(B0, 0, 0); PG8_SCHED; PG8_LDA(At, 0, 0); PG8_STAGE(PG8_SA(1, 1), a1 + hstep, voffA);
            PG8_WAIT_L(8); PG8_BAR; PG8_WAIT_L(0); PG8_MMA(0, 0, At, B0); PG8_BAR; PG8_SCHED;
            PG8_LDB(B1, 0, 1); PG8_STAGE(PG8_SB(0, 0), b2, voffB);
            PG8_BAR; PG8_WAIT_L(0); PG8_MMA(0, 1, At, B1); PG8_BAR;
            PG8_LDA(At, 0, 1); PG8_STAGE(PG8_SA(0, 0), a2, voffA);
            PG8_BAR; PG8_WAIT_L(0); PG8_MMA(1, 0, At, B0); PG8_BAR; PG8_SCHED;
            PG8_STAGE(PG8_SB(0, 1), b2 + hstep, voffB);
            PG8_WAIT_V(6); PG8_BAR; PG8_MMA(1, 1, At, B1); PG8_BAR;
            PG8_LDB(B0, 1, 0); PG8_SCHED; PG8_LDA(At, 1, 0); PG8_STAGE(PG8_SA(0, 1), a2 + hstep, voffA);
            PG8_WAIT_L(8); PG8_BAR; PG8_WAIT_L(0); PG8_MMA(0, 0, At, B0); PG8_BAR; PG8_SCHED;
            PG8_LDB(B1, 1, 1); PG8_STAGE(PG8_SB(1, 0), b3, voffB);
            PG8_BAR; PG8_WAIT_L(0); PG8_MMA(0, 1, At, B1); PG8_BAR;
            PG8_LDA(At, 1, 1); PG8_STAGE(PG8_SA(1, 0), a3, voffA);
            PG8_BAR; PG8_WAIT_L(0); PG8_MMA(1, 0, At, B0); PG8_BAR; PG8_SCHED;
            PG8_STAGE(PG8_SB(1, 1), b3 + hstep, voffB);
            PG8_WAIT_V(6); PG8_BAR; PG8_MMA(1, 1, At, B1); PG8_BAR;
            }
        }
        if constexpr (ALIGN_EPI) { if (wr == 0) PG8_BAR; }
        if constexpr (!Epi::AFTER_DRAIN) { E(acc, cur, wr, wc, fr, fq); S.done(cur); }
        if (!has_next) break;
#pragma unroll
        for (int a = 0; a < 2; ++a)
#pragma unroll
            for (int b = 0; b < 2; ++b)
#pragma unroll
                for (int m = 0; m < 4; ++m)
#pragma unroll
                    for (int n = 0; n < 2; ++n) acc[a][b][m][n] = (f32x4){0.f, 0.f, 0.f, 0.f};
        cur = nxt; cA = nA; cB = nB; ++ui;
        if constexpr (ALIGN_EPI) { if (wr == 1) PG8_BAR; }
    }
    PG8_WAIT_V(0);
    if constexpr (!ALIGN_EPI) { if (wr == 0) PG8_BAR; }
    PG8_BAR;
    if constexpr (Epi::AFTER_DRAIN) { E.fused(acc, cur, wr, wc, fr, fq, lds, wid, lane); S.done(cur); }
#undef PG8_SA
#undef PG8_SB
#undef PG8_STAGE
#undef PG8_LDA
#undef PG8_LDB
#undef PG8_MMA
#undef PG8_WAIT_V
#undef PG8_WAIT_L
#undef PG8_BAR
#undef PG8_SCHED
}
}
namespace att {
using bf16x8 = __attribute__((ext_vector_type(8))) short;
using s16x4  = __attribute__((ext_vector_type(4))) short;
using f32x16 = __attribute__((ext_vector_type(16))) float;
using u32x4  = __attribute__((ext_vector_type(4))) unsigned;
typedef unsigned short bf16_t;
constexpr int NW = 8, QBLK = 32, KVBLK = 64;
constexpr float SCALE = 0.07216878364870322f;
constexpr float THR = 8.f;
constexpr int LDQ = 1536, LDKV = 2048, LDKR = 64, LDG = 1024;
constexpr int SHM_V = KVBLK * 128 * 2, SHM_K = KVBLK * 192 * 2, SHM_ATTN = 3 * SHM_V + 3 * SHM_K + NW * 64 * 4 + NW * 4096;
#define KSWZ(row, colB) ((row) * 384 + ((colB) ^ ((((row) >> 1) & 7) << 4)))
#define SBAR() __builtin_amdgcn_sched_barrier(0)
__device__ __forceinline__ int crow(int r, int hi) { return (r & 3) + 8 * (r >> 2) + 4 * hi; }
__device__ __forceinline__ unsigned cvtpk(float lo, float hi) { unsigned r; asm volatile("v_cvt_pk_bf16_f32 %0, %1, %2" : "=v"(r) : "v"(lo), "v"(hi)); return r; }
__device__ __forceinline__ void partialSM(f32x16& p0, f32x16& p1, float& m_reg, float& mn, float& alpha) {
  constexpr float C = SCALE * 1.4426950408889634f;
  float pmax = p0[0];
#pragma unroll
  for (int r = 1; r < 16; ++r) pmax = fmaxf(pmax, p0[r]);
#pragma unroll
  for (int r = 0; r < 16; ++r) pmax = fmaxf(pmax, p1[r]);
  { auto rr = __builtin_amdgcn_permlane32_swap(__float_as_uint(pmax), __float_as_uint(pmax), false, false);
    pmax = fmaxf(__uint_as_float(rr[0]), __uint_as_float(rr[1])); }
  if (__builtin_expect(__all(pmax - m_reg <= THR / SCALE), 1)) { mn = m_reg; alpha = 1.f; }
  else { mn = fmaxf(m_reg, pmax); alpha = __builtin_amdgcn_exp2f((m_reg - mn) * C); m_reg = mn; }
  float mnC = -mn * C;
#pragma unroll
  for (int r = 0; r < 16; ++r) p0[r] = fmaf(p0[r], C, mnC);
#pragma unroll
  for (int r = 0; r < 16; ++r) p1[r] = fmaf(p1[r], C, mnC);
#pragma unroll
  for (int r = 0; r < 16; ++r) p0[r] = __builtin_amdgcn_exp2f(p0[r]);
}
__device__ __forceinline__ void finishSM(f32x16& p0, f32x16& p1, float alpha, float& l_reg, bf16x8& pa0, bf16x8& pa1, bf16x8& pa2, bf16x8& pa3) {
#pragma unroll
  for (int r = 0; r < 16; ++r) p1[r] = __builtin_amdgcn_exp2f(p1[r]);
  float ps = 0;
#pragma unroll
  for (int r = 0; r < 16; ++r) ps += p0[r];
#pragma unroll
  for (int r = 0; r < 16; ++r) ps += p1[r];
  { auto rr = __builtin_amdgcn_permlane32_swap(__float_as_uint(ps), __float_as_uint(ps), false, false);
    ps = __uint_as_float(rr[0]) + __uint_as_float(rr[1]); }
  l_reg = l_reg * alpha + ps;
#define PK4(P, BASE, OUT) do { unsigned a0 = cvtpk(P[BASE + 0], P[BASE + 1]), a1 = cvtpk(P[BASE + 2], P[BASE + 3]);   \
    unsigned b0 = cvtpk(P[BASE + 4], P[BASE + 5]), b1 = cvtpk(P[BASE + 6], P[BASE + 7]);                              \
    auto r0 = __builtin_amdgcn_permlane32_swap(a0, b0, false, false); auto r1 = __builtin_amdgcn_permlane32_swap(a1, b1, false, false); \
    u32x4 w = {r0[0], r1[0], r0[1], r1[1]}; OUT = *reinterpret_cast<bf16x8*>(&w); } while (0)
  PK4(p0, 0, pa0); PK4(p0, 8, pa1); PK4(p1, 0, pa2); PK4(p1, 8, pa3);
#undef PK4
}
__device__ __forceinline__ void qkt(f32x16& p0, f32x16& p1, const char* Ks, const bf16x8* qr, const char* qrl, int r32, int hi) {
  p0 = f32x16{}; p1 = f32x16{};
#pragma unroll
  for (int d0 = 0; d0 < 8; ++d0) { int cb = (d0 * 16 + hi * 8) * 2;
    bf16x8 b0 = *reinterpret_cast<const bf16x8*>(Ks + KSWZ(r32, cb));
    bf16x8 b1 = *reinterpret_cast<const bf16x8*>(Ks + KSWZ(32 + r32, cb));
    p0 = __builtin_amdgcn_mfma_f32_32x32x16_bf16(b0, qr[d0], p0, 0, 0, 0);
    p1 = __builtin_amdgcn_mfma_f32_32x32x16_bf16(b1, qr[d0], p1, 0, 0, 0); }
#pragma unroll
  for (int d0 = 8; d0 < 12; ++d0) { int cb = (d0 * 16 + hi * 8) * 2;
    bf16x8 b0 = *reinterpret_cast<const bf16x8*>(Ks + KSWZ(r32, cb));
    bf16x8 b1 = *reinterpret_cast<const bf16x8*>(Ks + KSWZ(32 + r32, cb));
    bf16x8 qf = *reinterpret_cast<const bf16x8*>(qrl + (((2 * (d0 - 8) + hi) ^ ((r32 >> 1) & 7)) << 4));
    p0 = __builtin_amdgcn_mfma_f32_32x32x16_bf16(b0, qf, p0, 0, 0, 0);
    p1 = __builtin_amdgcn_mfma_f32_32x32x16_bf16(b1, qf, p1, 0, 0, 0); }
}
__device__ __forceinline__ int v_st(int k, int c) { const int kk = (k & ~0xC) | ((k & 4) << 1) | ((k & 8) >> 1); return ((kk >> 3) * 4 + (c >> 5)) * 512 + ((kk & 7) * 32 + (c & 31)) * 2; }
__device__ __forceinline__ int v_rd_base(int lane) { return ((lane & 3) << 3) | (((lane >> 2) & 3) << 6) | (((lane >> 4) & 1) << 5) | (((lane >> 5) & 1) << 8); }
constexpr int v_rd_off(int d0, int ks, int half) { return d0 * 512 + ks * 4096 + half * 2048; }
template <int OFF> __device__ __forceinline__ s16x4 tr_read(int vb) {
  s16x4 r; asm volatile("ds_read_b64_tr_b16 %0, %1 offset:%2" : "=&v"(r) : "v"(vb), "i"(OFF) : "memory"); return r;
}
template <int D0> __device__ __forceinline__ void pv_one(f32x16& od, int vb, bf16x8 pa0, bf16x8 pa1, bf16x8 pa2, bf16x8 pa3) {
  const s16x4 l0 = tr_read<v_rd_off(D0, 0, 0)>(vb), h0 = tr_read<v_rd_off(D0, 0, 1)>(vb), l1 = tr_read<v_rd_off(D0, 1, 0)>(vb), h1 = tr_read<v_rd_off(D0, 1, 1)>(vb);
  const s16x4 l2 = tr_read<v_rd_off(D0, 2, 0)>(vb), h2 = tr_read<v_rd_off(D0, 2, 1)>(vb), l3 = tr_read<v_rd_off(D0, 3, 0)>(vb), h3 = tr_read<v_rd_off(D0, 3, 1)>(vb);
  asm volatile("s_waitcnt lgkmcnt(0)" ::: "memory"); SBAR();
#define PK(L, H) (bf16x8){L[0], L[1], L[2], L[3], H[0], H[1], H[2], H[3]}
  od = __builtin_amdgcn_mfma_f32_32x32x16_bf16(pa0, PK(l0, h0), od, 0, 0, 0);
  od = __builtin_amdgcn_mfma_f32_32x32x16_bf16(pa1, PK(l1, h1), od, 0, 0, 0);
  od = __builtin_amdgcn_mfma_f32_32x32x16_bf16(pa2, PK(l2, h2), od, 0, 0, 0);
  od = __builtin_amdgcn_mfma_f32_32x32x16_bf16(pa3, PK(l3, h3), od, 0, 0, 0);
#undef PK
}
__device__ __forceinline__ void pv_d0(f32x16* o, int vb, bf16x8 pa0, bf16x8 pa1, bf16x8 pa2, bf16x8 pa3) {
  pv_one<0>(o[0], vb, pa0, pa1, pa2, pa3); pv_one<1>(o[1], vb, pa0, pa1, pa2, pa3); pv_one<2>(o[2], vb, pa0, pa1, pa2, pa3); pv_one<3>(o[3], vb, pa0, pa1, pa2, pa3);
}
__device__ __forceinline__ void attn_unit(const bf16_t* __restrict__ Qb, const bf16_t* __restrict__ Kn, const bf16_t* __restrict__ Vh, const bf16_t* __restrict__ Kr,
                                          bf16_t* GO, int seq, char* lds, const int tid) {
  const int wid = tid >> 6, lane = tid & 63, r32 = lane & 31, hi = lane >> 5;
  char* V_lds = lds; char* K_lds = lds + 3 * SHM_V;
  float* ws = (float*)(lds + 3 * SHM_V + 3 * SHM_K) + wid * 64; float* li_l = ws; float* al_l = ws + 32;
  if (wid < 4) __builtin_amdgcn_s_setprio(2); else __builtin_amdgcn_s_setprio(0);
  float m_reg = -1e30f, l_reg = 0; f32x16 o[4] = {}; bf16x8 qr[8];
  char* qrl = lds + 3 * SHM_V + 3 * SHM_K + NW * 64 * 4 + wid * 4096 + r32 * 128;
  const bf16_t* Qw = Qb + (long)(wid * QBLK + r32) * LDQ + hi * 8;
#pragma unroll
  for (int d0 = 0; d0 < 8; ++d0) qr[d0] = *reinterpret_cast<const bf16x8*>(Qw + d0 * 16);
#pragma unroll
  for (int d0 = 8; d0 < 12; ++d0) *reinterpret_cast<bf16x8*>(qrl + (((2 * (d0 - 8) + hi) ^ ((r32 >> 1) & 7)) << 4)) = *reinterpret_cast<const bf16x8*>(Qw + d0 * 16);
  const int sr = tid >> 4, sc = (tid & 15) * 8, vst0 = v_st(sr, sc), vst1 = v_st(32 + sr, sc);
  const int rr = tid >> 3, rc = (tid & 7) * 8;
  const int vb0 = (int)(uintptr_t)V_lds + v_rd_base(lane);
  const unsigned offkv = (unsigned)(sr * LDKV + sc) * 2u, offkr = (unsigned)(rr * LDKR + rc) * 2u;
  struct { bf16x8 vs0, vs1, ks0, ks1, kr; } sr_[1];
#define SLOAD(i, k0) do { const char* kb_ = (const char*)Kn + (size_t)(k0) * (LDKV * 2); const char* kr_ = (const char*)Kr + (size_t)(k0) * (LDKR * 2); \
    sr_[i].vs0 = *(const bf16x8*)(kb_ + 256 + offkv); sr_[i].vs1 = *(const bf16x8*)(kb_ + 32 * LDKV * 2 + 256 + offkv); \
    sr_[i].ks0 = *(const bf16x8*)(kb_ + offkv); sr_[i].ks1 = *(const bf16x8*)(kb_ + 32 * LDKV * 2 + offkv); \
    sr_[i].kr = *(const bf16x8*)(kr_ + offkr); } while (0)
#define SWRITE(b, i) do { *(bf16x8*)(V_lds + (b) * SHM_V + vst0) = sr_[i].vs0;          \
    *(bf16x8*)(V_lds + (b) * SHM_V + vst1) = sr_[i].vs1; int kc = sc * 2;               \
    *(bf16x8*)(K_lds + (b) * SHM_K + KSWZ(sr, kc)) = sr_[i].ks0;                       \
    *(bf16x8*)(K_lds + (b) * SHM_K + KSWZ(32 + sr, kc)) = sr_[i].ks1;                  \
    *(bf16x8*)(K_lds + (b) * SHM_K + KSWZ(rr, 256 + rc * 2)) = sr_[i].kr; } while (0)
#define SWAIT() asm volatile("s_waitcnt vmcnt(0)" ::: "memory")
#define RESC(a) do { if (__any((a) < 1.f)) { if (hi == 0) al_l[r32] = (a); asm volatile("s_waitcnt lgkmcnt(0)" ::: "memory"); \
    _Pragma("unroll") for (int d = 0; d < 4; ++d) _Pragma("unroll") for (int r = 0; r < 16; ++r) o[d][r] *= al_l[crow(r, hi)]; } } while (0)
  f32x16 pA0, pA1, pB0, pB1; float mnA, mnB, alA, alB; bf16x8 pa0, pa1, pa2, pa3; const int NT = seq / KVBLK;
#define LBAR() do { asm volatile("s_waitcnt lgkmcnt(0)" ::: "memory"); __builtin_amdgcn_s_barrier(); asm volatile("" ::: "memory"); } while (0)
  SLOAD(0, 0); SWRITE(0, 0); SLOAD(0, KVBLK); LBAR();
  qkt(pA0, pA1, K_lds, qr, qrl, r32, hi); partialSM(pA0, pA1, m_reg, mnA, alA);
  SWRITE(1, 0); if (2 < NT) SLOAD(0, 2 * KVBLK); LBAR();
  int bc = 1;
  for (int j = 1; j + 1 < NT; j += 2) {
    const int bp = bc == 0 ? 2 : bc - 1, bn = bc == 2 ? 0 : bc + 1;
    SBAR(); qkt(pB0, pB1, K_lds + bc * SHM_K, qr, qrl, r32, hi);
    finishSM(pA0, pA1, alA, l_reg, pa0, pa1, pa2, pa3); SBAR();
    SWRITE(bn, 0); SLOAD(0, (j + 2) * KVBLK); SBAR();
    pv_d0(o, vb0 + bp * SHM_V, pa0, pa1, pa2, pa3); partialSM(pB0, pB1, m_reg, mnB, alB);
    RESC(alB); LBAR();
    SBAR(); qkt(pA0, pA1, K_lds + bn * SHM_K, qr, qrl, r32, hi);
    finishSM(pB0, pB1, alB, l_reg, pa0, pa1, pa2, pa3); SBAR();
    SWRITE(bp, 0); if (j + 3 < NT) SLOAD(0, (j + 3) * KVBLK); SBAR();
    pv_d0(o, vb0 + bc * SHM_V, pa0, pa1, pa2, pa3); partialSM(pA0, pA1, m_reg, mnA, alA);
    RESC(alA); LBAR();
    bc = bp;
  }
  { const int bp = bc == 0 ? 2 : bc - 1;
    SBAR(); qkt(pB0, pB1, K_lds + bc * SHM_K, qr, qrl, r32, hi);
    finishSM(pA0, pA1, alA, l_reg, pa0, pa1, pa2, pa3); SBAR();
    pv_d0(o, vb0 + bp * SHM_V, pa0, pa1, pa2, pa3); partialSM(pB0, pB1, m_reg, mnB, alB);
    RESC(alB);
    finishSM(pB0, pB1, alB, l_reg, pa0, pa1, pa2, pa3); SBAR();
    pv_d0(o, vb0 + bc * SHM_V, pa0, pa1, pa2, pa3); }
#undef LBAR
  if (hi == 0) li_l[r32] = l_reg; asm volatile("s_waitcnt lgkmcnt(0)" ::: "memory");
  {
    const int erow = lane >> 3, ec8 = (lane & 7) * 8;
    bf16_t* gbase = GO + (long)(wid * QBLK + erow) * LDG + ec8;
    char* stg = qrl - r32 * 128;
    u32x4 gt[2][4];
#pragma unroll
    for (int half = 0; half < 2; ++half)
#pragma unroll
      for (int it = 0; it < 4; ++it) gt[half][it] = *(const u32x4*)(gbase + (long)(it * 8) * LDG + 64 * half);
    float rli[16];
#pragma unroll
    for (int r = 0; r < 16; ++r) rli[r] = __builtin_amdgcn_rcpf(li_l[crow(r, hi)]);
#pragma unroll
    for (int half = 0; half < 2; ++half) {
#pragma unroll
      for (int r = 0; r < 16; ++r) { const int orow = crow(r, hi);
        *(bf16_t*)(stg + orow * 128 + r32 * 2) = (bf16_t)(cvtpk(o[2 * half][r] * rli[r], 0.f) & 0xffffu);
        *(bf16_t*)(stg + orow * 128 + (32 + r32) * 2) = (bf16_t)(cvtpk(o[2 * half + 1][r] * rli[r], 0.f) & 0xffffu); }
      asm volatile("s_waitcnt lgkmcnt(0)" ::: "memory");
#pragma unroll
      for (int it = 0; it < 4; ++it) {
        const u32x4 ov = *(const u32x4*)(stg + (it * 8 + erow) * 128 + ec8 * 2); const u32x4 gv_ = gt[half][it];
        u32x4 w;
#define MULPK(A, B) cvtpk(__uint_as_float((A) << 16) * __uint_as_float((B) << 16), __uint_as_float((A) & 0xffff0000u) * __uint_as_float((B) & 0xffff0000u))
        w.x = MULPK(ov.x, gv_.x); w.y = MULPK(ov.y, gv_.y); w.z = MULPK(ov.z, gv_.z); w.w = MULPK(ov.w, gv_.w);
#undef MULPK
        *(u32x4*)(gbase + (long)(it * 8) * LDG + 64 * half) = w;
      }
      asm volatile("s_waitcnt lgkmcnt(0)" ::: "memory");
    }
  }
  __builtin_amdgcn_s_setprio(0);
#undef SLOAD
#undef SWRITE
#undef SWAIT
#undef RESC
}
}
#define LAS __attribute__((address_space(3)))
typedef unsigned short bf16;
typedef unsigned v4u __attribute__((ext_vector_type(4)));
typedef unsigned v2u __attribute__((ext_vector_type(2)));
typedef float f32x4 __attribute__((ext_vector_type(4)));
typedef float f32x2 __attribute__((ext_vector_type(2)));
typedef short bf16x8 __attribute__((ext_vector_type(8)));
typedef float f32x16 __attribute__((ext_vector_type(16)));
constexpr int NWAVES = 8, NTHR = 512, LDS_MISC = 157696;
#define RLX_AGENT __ATOMIC_RELAXED, __HIP_MEMORY_SCOPE_AGENT
#define XB_TMO      128
#define XB_XCNT(j)  (256  + 64 * (j))
#define XB_XSUB(j)  (1280 + 64 * (j))
#define XB_XGEN(j)  (2304 + 64 * (j))
#define XB_TOP      3328
#define XB_TOPGEN   3392
#define XCD_BAR_WORDS 3456
#define XB_SPIN_CAP (1u << 18)

__device__ __forceinline__ unsigned xb_ld(unsigned* p)              { return __hip_atomic_load(p, __ATOMIC_RELAXED, __HIP_MEMORY_SCOPE_AGENT); }
__device__ __forceinline__ unsigned xb_add(unsigned* p, unsigned v) { return __hip_atomic_fetch_add(p, v, __ATOMIC_RELAXED, __HIP_MEMORY_SCOPE_AGENT); }
__device__ __forceinline__ unsigned xb_xcc_id() { return (unsigned)__builtin_amdgcn_s_getreg((3 << 11) | 20) & 0xFu; }
#define XB_SPIN(cond, bar) do { unsigned _sp = 0; while (cond) { __builtin_amdgcn_s_sleep(1); \
    if ((++_sp & 255u) == 0u) { if (xb_ld(&(bar)[XB_TMO])) break; if (_sp > XB_SPIN_CAP) { atomicAdd(&(bar)[XB_TMO], 1u); break; } } } } while (0)

struct XcdBarrier {
    unsigned* bar; unsigned x;
    volatile LAS unsigned* st;
};

__device__ __forceinline__ XcdBarrier xcd_barrier_post(unsigned* bar, volatile LAS unsigned* st, bool t0) {
    XcdBarrier b; b.bar = bar; b.x = xb_xcc_id(); b.st = st;
    if (t0) (void)xb_add(&bar[XB_XCNT(b.x)], 1u);
    return b;
}
__device__ __forceinline__ void xcd_barrier_complete(unsigned* bar, unsigned x, unsigned& nloc, unsigned& nx) {
    const unsigned G = gridDim.x * gridDim.y * gridDim.z;
    unsigned sum, cnt, mine, sp = 0u;
    for (;;) {
        sum = 0u; cnt = 0u; mine = 0u;
#pragma unroll
        for (unsigned j = 0; j < 16; ++j) { const unsigned c = xb_ld(&bar[XB_XCNT(j)]); sum += c; cnt += (c > 0u) ? 1u : 0u; mine = (j == x) ? c : mine; }
        if (sum == G) break;
        __builtin_amdgcn_s_sleep(1);
        if ((++sp & 255u) == 0u) { if (xb_ld(&bar[XB_TMO])) break; if (sp > XB_SPIN_CAP) { atomicAdd(&bar[XB_TMO], 1u); break; } }
    }
    nloc = mine > 0u ? mine : 1u; nx = cnt > 0u ? cnt : 1u;
}

__device__ __forceinline__ void xcd_barrier(const XcdBarrier& b, bool t0) {
    asm volatile("s_waitcnt vmcnt(0)" ::: "memory");
    __syncthreads();
    if (t0) {
        unsigned* bar = b.bar; asm volatile("" : "+s"(bar));
        __builtin_amdgcn_s_waitcnt(0);
        unsigned nloc = b.st[0], nx = b.st[1];
        if (nloc == 0u) { xcd_barrier_complete(bar, b.x, nloc, nx); b.st[0] = nloc; b.st[1] = nx; }
        const unsigned old = xb_add(&bar[XB_XSUB(b.x)], 1u);
        const unsigned gen = old / nloc;
        if (old + 1u == (gen + 1u) * nloc) {
            __builtin_amdgcn_fence(__ATOMIC_RELEASE, "agent");
            asm volatile("s_waitcnt vmcnt(0)" ::: "memory");
            const unsigned og = xb_add(&bar[XB_TOP], 1u);
            const unsigned tg = og / nx;
            if (og + 1u == (tg + 1u) * nx) xb_add(&bar[XB_TOPGEN], 1u);
            else XB_SPIN(xb_ld(&bar[XB_TOPGEN]) == tg, bar);
            __builtin_amdgcn_fence(__ATOMIC_ACQUIRE, "agent");
            xb_add(&bar[XB_XGEN(b.x)], 1u);
            asm volatile("s_waitcnt vmcnt(0)" ::: "memory");
        } else {
            XB_SPIN(xb_ld(&bar[XB_XGEN(b.x)]) == gen, bar);
            __builtin_amdgcn_fence(__ATOMIC_ACQUIRE, "agent");
            asm volatile("s_waitcnt vmcnt(0)" ::: "memory");
        }
    }
    __syncthreads();
}

constexpr int DM = 1024, M_TOT = 49152, M_G0 = 32768;
constexpr size_t MiB = 1u << 20, KiB = 1u << 10;
constexpr size_t WS_ROPE = 0;
constexpr size_t WS_STATS = 504 * MiB;
constexpr size_t WS_WS = 3 * MiB + 512 * KiB;
constexpr size_t WS_AIN = 4 * MiB, WS_QUP = 11 * MiB, WS_KVUP = 13 * MiB + 256 * KiB, WS_AOUT = 15 * MiB + 256 * KiB, WS_BIN = 19 * MiB + 256 * KiB, WS_BOUT = 43 * MiB + 256 * KiB;
constexpr size_t WS_H = 52 * MiB;
constexpr size_t WS_GATE = 148 * MiB, WS_QLAT = 244 * MiB, WS_KVLAT = 280 * MiB, WS_KROPE = 304 * MiB, WS_KV = 310 * MiB;
constexpr size_t WS_UG = 148 * MiB, WS_GV = 340 * MiB;
constexpr size_t WS_Q1 = 438 * MiB;
constexpr size_t WS_END = 486 * MiB;
constexpr int LDS_BYTES = 158720;

__device__ __forceinline__ unsigned f2bf(float f) { unsigned u = __builtin_bit_cast(unsigned, f); return (u + 0x7fffu + ((u >> 16) & 1u)) >> 16; }
__device__ __forceinline__ unsigned pk2(float lo, float hi) { return f2bf(lo) | (f2bf(hi) << 16); }
__device__ __forceinline__ float wave_sum(float v) {
#pragma unroll
    for (int o = 1; o < 64; o <<= 1) v += __shfl_xor(v, o);
    return v;
}
__device__ __forceinline__ int srccol(int mode, int n) {
    if (mode == 1) {
        if (n < 256) return 384 + n;
        if (n < 640) return n - 256;
        if (n < 704) { const int j = n - 640; return 640 + (j >> 1) + 32 * (j & 1); }
        if (n < 768) return -1;
        return 704 + (n - 768);
    }
    if (mode == 2) { const int h = n / 192, d = n % 192; if (d < 128) return n; const int j = d - 128; return h * 192 + 128 + (j >> 1) + 32 * (j & 1); }
    if (mode == 3) { if (n < 2048) return 2048 + n; const int t = (n - 2048) >> 8, r = (n - 2048) & 255; return r < 128 ? 128 * t + r : 4096 + 128 * t + (r - 128); }
    return n;
}
__device__ __forceinline__ void transpose_item(const float* W, int K, int N, int Nout, bf16* WT, LAS float* scr, int item, int lane, int mode, const float* kscale) {
    const int nblk = Nout / 32, kb = item / nblk, nb = item % nblk, k0 = 64 * kb, n0 = 32 * nb;
    const int src = srccol(mode, n0 + (lane & 31));
    float wv[32], ks[32];
#pragma unroll
    for (int i = 0; i < 32; ++i) { const int kk = 2 * i + (lane >> 5); wv[i] = (src >= 0) ? W[(size_t)(k0 + kk) * N + src] : 0.f; ks[i] = kscale ? kscale[k0 + kk] : 1.f; }
#pragma unroll
    for (int i = 0; i < 32; ++i) { const int kk = 2 * i + (lane >> 5); scr[kk * 33 + (lane & 31)] = wv[i] * ks[i]; }
    asm volatile("s_waitcnt lgkmcnt(0)" ::: "memory");
    const int c = lane & 7;
#pragma unroll
    for (int j = 0; j < 4; ++j) { const int n = (lane >> 3) + 8 * j; const LAS float* s = scr + (8 * c) * 33 + n;
        v4u o; o.x = pk2(s[0 * 33], s[1 * 33]); o.y = pk2(s[2 * 33], s[3 * 33]); o.z = pk2(s[4 * 33], s[5 * 33]); o.w = pk2(s[6 * 33], s[7 * 33]);
        *(v4u*)(WT + (size_t)(n0 + n) * K + k0 + 8 * c) = o; }
    asm volatile("s_waitcnt lgkmcnt(0)" ::: "memory");
}
template <bool FINAL>
__device__ __forceinline__ void rms_row(const float* xrow, const float* g, bf16* orow, float* frow, int lane, pg8::fx_t* ssq_out = nullptr) {
    const f32x4* xr = (const f32x4*)xrow + lane; const f32x4* gr = (const f32x4*)g + lane;
    f32x4 v[4]; float s = 0.f;
#pragma unroll
    for (int j = 0; j < 4; ++j) { v[j] = xr[64 * j]; s += (v[j].x * v[j].x + v[j].y * v[j].y) + (v[j].z * v[j].z + v[j].w * v[j].w); }
    const float tot = wave_sum(s); const float rstd = FINAL ? 1.0f / sqrtf(tot * (1.0f / 1024.0f) + 1e-6f) : 1.0f;
    if (!FINAL) { if (lane == 0) *ssq_out = (pg8::fx_t)(long long)(tot * 16777216.0f); }
#pragma unroll
    for (int j = 0; j < 4; ++j) { const f32x4 gg = FINAL ? gr[64 * j] : (f32x4){1.f, 1.f, 1.f, 1.f}; const f32x4 y = v[j] * rstd * gg;
        if (FINAL) ((f32x4*)frow + lane)[64 * j] = y;
        else { v2u w; w.x = pk2(y.x, y.y); w.y = pk2(y.z, y.w); ((v2u*)orow + lane)[64 * j] = w; } }
}
__device__ __forceinline__ void norm_phase(const float* x0, const float* x1  , const float* g, bf16* Hb, pg8::fx_t* ssq, int gw, int NGW, int lane) {
    int m = gw;
    for (; m + 3 * NGW < M_TOT; m += 4 * NGW) {
        f32x4 v[4][4];
#pragma unroll
        for (int r = 0; r < 4; ++r) { const int mm = m + r * NGW; const f32x4* xr = (const f32x4*)((mm < M_G0 ? x0 : x1) + (size_t)mm * DM) + lane;
#pragma unroll
            for (int j = 0; j < 4; ++j) v[r][j] = xr[64 * j]; }
#pragma unroll
        for (int r = 0; r < 4; ++r) { const int mm = m + r * NGW; float s = 0.f;
#pragma unroll
            for (int j = 0; j < 4; ++j) s += (v[r][j].x * v[r][j].x + v[r][j].y * v[r][j].y) + (v[r][j].z * v[r][j].z + v[r][j].w * v[r][j].w);
            const float tot = wave_sum(s); if (lane == 0) ssq[mm] = (pg8::fx_t)(long long)(tot * 16777216.0f);
#pragma unroll
            for (int j = 0; j < 4; ++j) { v2u w; w.x = pk2(v[r][j].x, v[r][j].y); w.y = pk2(v[r][j].z, v[r][j].w); ((v2u*)(Hb + (size_t)mm * DM) + lane)[64 * j] = w; } }
    }
    for (; m < M_TOT; m += NGW) rms_row<false>((m < M_G0 ? x0 : x1) + (size_t)m * DM, g, Hb + (size_t)m * DM, nullptr, lane, ssq + m);
}
__device__ __forceinline__ void spatial_unit(char* lds, const bf16* gvl  , const bf16* ugp  , bf16* outp, const pg8::fx_t* s1, const pg8::fx_t* s2  ,
                                              const bf16* wsg  , const float* lng, const float* lnb  , const float* bsg  , int g, int tid) {
    char* Wl = lds; char* VT = lds + 34816; float* mu = (float*)(lds + 34816 + 69632); float* rs = mu + 128;
    const int lane = tid & 63, wid = tid >> 6, r32 = lane & 31, hi = lane >> 5;
    if (tid < 128) { const float a = pg8::fx_get(s1 + tid) * (1.0f / 2048.0f), b = pg8::fx_get(s2 + tid) * (1.0f / 2048.0f); mu[tid] = a; rs[tid] = 1.0f / sqrtf(fmaxf(b - a * a, 0.f) + 1e-5f); }
#pragma unroll
    for (int i = 0; i < 4; ++i) { const int id = tid + 512 * i, p = id >> 4, qc = (id & 15) * 8; *(v4u*)(Wl + p * 272 + qc * 2) = *(const v4u*)(wsg + p * 128 + qc); }
    __syncthreads();
    {
        const int cc = (tid >> 3) & 31, c0 = 8 * cc;
        float lg[8], lb[8];
#pragma unroll
        for (int j = 0; j < 8; ++j) { lg[j] = lng[c0 + j]; lb[j] = lnb[c0 + j]; }
#pragma unroll
        for (int i = 0; i < 8; ++i) {
            const int q = (tid & 7) + 8 * ((tid >> 8) + 2 * i);
            const v4u raw = *(const v4u*)(gvl + (size_t)q * 2048 + g * 256 + c0);
            const float m_ = mu[q], r_ = rs[q];
            const unsigned wds[4] = {raw.x, raw.y, raw.z, raw.w};
#pragma unroll
            for (int j = 0; j < 8; ++j) { const unsigned wd = wds[j >> 1]; const float v = __uint_as_float((j & 1) ? (wd & 0xffff0000u) : (wd << 16));
                const float y = (v - m_) * r_ * lg[j] + lb[j]; const int c = c0 + j;
                *(bf16*)(VT + c * 272 + (((q >> 3) ^ ((c >> 3) & 7)) * 16) + (q & 7) * 2) = (bf16)f2bf(y); }
        }
    }
    __syncthreads();
    {
        const int c = 32 * wid + r32;
        bf16x8 a[8];
#pragma unroll
        for (int ks = 0; ks < 8; ++ks) a[ks] = *(const bf16x8*)(VT + c * 272 + (((2 * ks + hi) ^ ((c >> 3) & 7)) * 16));
        f32x16 acc[4];
#pragma unroll
        for (int pt = 0; pt < 4; ++pt) {
            acc[pt] = f32x16{};
            const int p = 32 * pt + r32;
#pragma unroll
            for (int ks = 0; ks < 8; ++ks) { const bf16x8 b = *(const bf16x8*)(Wl + p * 272 + (16 * ks + 8 * hi) * 2); acc[pt] = __builtin_amdgcn_mfma_f32_32x32x16_bf16(a[ks], b, acc[pt], 0, 0, 0); }
        }
        __syncthreads();
#pragma unroll
        for (int pt = 0; pt < 4; ++pt) {
            const int p = 32 * pt + r32; const float bias = bsg[p];
#pragma unroll
            for (int r4 = 0; r4 < 4; ++r4) { v2u w; w.x = pk2(acc[pt][4 * r4 + 0] + bias, acc[pt][4 * r4 + 1] + bias); w.y = pk2(acc[pt][4 * r4 + 2] + bias, acc[pt][4 * r4 + 3] + bias);
                *(v2u*)(VT + p * 528 + (32 * wid + 8 * r4 + 4 * hi) * 2) = w; }
        }
    }
    __syncthreads();
#pragma unroll
    for (int i = 0; i < 8; ++i) {
        const int id = tid + 512 * i, p = id >> 5, c0 = (id & 31) * 8; const size_t off = (size_t)p * 2048 + g * 256 + c0;
        const v4u sv = *(const v4u*)(VT + p * 528 + c0 * 2); const v4u uu = *(const v4u*)(ugp + off);
        v4u w;
        w.x = pk2(__uint_as_float(uu.x << 16) * __uint_as_float(sv.x << 16), __uint_as_float(uu.x & 0xffff0000u) * __uint_as_float(sv.x & 0xffff0000u));
        w.y = pk2(__uint_as_float(uu.y << 16) * __uint_as_float(sv.y << 16), __uint_as_float(uu.y & 0xffff0000u) * __uint_as_float(sv.y & 0xffff0000u));
        w.z = pk2(__uint_as_float(uu.z << 16) * __uint_as_float(sv.z << 16), __uint_as_float(uu.z & 0xffff0000u) * __uint_as_float(sv.z & 0xffff0000u));
        w.w = pk2(__uint_as_float(uu.w << 16) * __uint_as_float(sv.w << 16), __uint_as_float(uu.w & 0xffff0000u) * __uint_as_float(sv.w & 0xffff0000u));
        *(v4u*)(outp + off) = w;
    }
    __syncthreads();
}

__device__ __forceinline__ void spatial_phase(char* lds, const bf16* gv0, const bf16* gv1  , bf16* ug, const pg8::fx_t* s1, const pg8::fx_t* s2,
                                               const bf16* ws_l  , const float* lng_l, const float* lnb_l  , const float* bs_l  , int bid, int G, int tid) {
    char* Wl = lds; char* VT = lds + 34816; float* mu = (float*)(lds + 34816 + 69632); float* rs = mu + 128;
    const int lane = tid & 63, wid = tid >> 6, r32 = lane & 31, hi = lane >> 5;
    const int total = (M_TOT / 128) * 8;
    int ui = bid; if (ui >= total) return;
    const int cc = (tid >> 3) & 31, c0n = 8 * cc, q0 = (tid & 7) + 8 * (tid >> 8);
    v4u gvr[8], ugr[8]; float lg[8], lb[8]; int prev_gg = -1;
    const unsigned voffg = (unsigned)(q0 * 2048 + c0n) * 2u, voffu = (unsigned)((tid >> 5) * 2048 + (tid & 31) * 8) * 2u;
#define SP_GVP(u_) (((u_) >> 3) < M_G0 / 128 ? gv0 + (size_t)((u_) >> 3) * 128 * 2048 : gv1 + ((size_t)((u_) >> 3) * 128 - M_G0) * 2048)
#define SP_LOADGV(u_) do { const char* gp_ = (const char*)(SP_GVP(u_) + ((u_) & 7) * 256); _Pragma("unroll") for (int i = 0; i < 8; ++i) gvr[i] = *(const v4u*)(gp_ + (size_t)i * 65536 + voffg); } while (0)
    SP_LOADGV(ui);
    pg8::fx_t st1 = 0, st2 = 0;
    if (tid < 128) { st1 = s1[(size_t)(ui >> 3) * 128 + tid]; st2 = s2[(size_t)(ui >> 3) * 128 + tid]; }
    for (;;) {
        const int ch = ui >> 3, gg = ui & 7; const size_t grow = (size_t)ch * 128;
        if (tid < 128) { const float a = pg8::fx_get(&st1) * (1.0f / 2048.0f), b = pg8::fx_get(&st2) * (1.0f / 2048.0f); mu[tid] = a; rs[tid] = 1.0f / sqrtf(fmaxf(b - a * a, 0.f) + 1e-5f); }
        if (gg != prev_gg) {
            const bf16* wsg = ws_l + (size_t)gg * 128 * 128;
#pragma unroll
            for (int i = 0; i < 4; ++i) { const int id = tid + 512 * i, p = id >> 4, qc = (id & 15) * 8; *(v4u*)(Wl + p * 272 + qc * 2) = *(const v4u*)(wsg + p * 128 + qc); }
#pragma unroll
            for (int j = 0; j < 8; ++j) { lg[j] = lng_l[gg * 256 + c0n + j]; lb[j] = lnb_l[gg * 256 + c0n + j]; }
            prev_gg = gg;
        }
        __syncthreads();
#pragma unroll
        for (int i = 0; i < 8; ++i) {
            const int q = q0 + 16 * i; const v4u raw = gvr[i];
            const float m_ = mu[q], r_ = rs[q];
            const unsigned wds[4] = {raw.x, raw.y, raw.z, raw.w};
#pragma unroll
            for (int j = 0; j < 8; ++j) { const unsigned wd = wds[j >> 1]; const float v = __uint_as_float((j & 1) ? (wd & 0xffff0000u) : (wd << 16));
                const float y = (v - m_) * r_ * lg[j] + lb[j]; const int c = c0n + j;
                *(bf16*)(VT + c * 272 + (((q >> 3) ^ ((c >> 3) & 7)) * 16) + (q & 7) * 2) = (bf16)f2bf(y); }
        }
        const int nxt = ui + G;
        if (nxt < total) { SP_LOADGV(nxt); if (tid < 128) { st1 = s1[(size_t)(nxt >> 3) * 128 + tid]; st2 = s2[(size_t)(nxt >> 3) * 128 + tid]; } }
        bf16* ugp = ug + grow * 2048 + gg * 256;
        __syncthreads();
        {
            const int c = 32 * wid + r32;
            bf16x8 a[8];
#pragma unroll
            for (int ks = 0; ks < 8; ++ks) a[ks] = *(const bf16x8*)(VT + c * 272 + (((2 * ks + hi) ^ ((c >> 3) & 7)) * 16));
            f32x16 acc[4];
#pragma unroll
            for (int pt = 0; pt < 4; ++pt) {
                acc[pt] = f32x16{};
                const int p = 32 * pt + r32;
#pragma unroll
                for (int ks = 0; ks < 8; ++ks) { const bf16x8 b = *(const bf16x8*)(Wl + p * 272 + (16 * ks + 8 * hi) * 2); acc[pt] = __builtin_amdgcn_mfma_f32_32x32x16_bf16(a[ks], b, acc[pt], 0, 0, 0); }
            }
#pragma unroll
            for (int i = 0; i < 8; ++i) ugr[i] = *(const v4u*)((const char*)ugp + (size_t)i * 65536 + voffu);
            __syncthreads();
#pragma unroll
            for (int pt = 0; pt < 4; ++pt) {
                const int p = 32 * pt + r32; const float bias = bs_l[gg * 128 + p];
#pragma unroll
                for (int r4 = 0; r4 < 4; ++r4) { v2u w; w.x = pk2(acc[pt][4 * r4 + 0] + bias, acc[pt][4 * r4 + 1] + bias); w.y = pk2(acc[pt][4 * r4 + 2] + bias, acc[pt][4 * r4 + 3] + bias);
                    *(v2u*)(VT + p * 528 + (32 * wid + 8 * r4 + 4 * hi) * 2) = w; }
            }
        }
        __syncthreads();
#pragma unroll
        for (int i = 0; i < 8; ++i) {
            const int id = tid + 512 * i, p = id >> 5, c0 = (id & 31) * 8;
            const v4u sv = *(const v4u*)(VT + p * 528 + c0 * 2); const v4u uu = ugr[i];
            v4u w;
            w.x = pk2(__uint_as_float(uu.x << 16) * __uint_as_float(sv.x << 16), __uint_as_float(uu.x & 0xffff0000u) * __uint_as_float(sv.x & 0xffff0000u));
            w.y = pk2(__uint_as_float(uu.y << 16) * __uint_as_float(sv.y << 16), __uint_as_float(uu.y & 0xffff0000u) * __uint_as_float(sv.y & 0xffff0000u));
            w.z = pk2(__uint_as_float(uu.z << 16) * __uint_as_float(sv.z << 16), __uint_as_float(uu.z & 0xffff0000u) * __uint_as_float(sv.z & 0xffff0000u));
            w.w = pk2(__uint_as_float(uu.w << 16) * __uint_as_float(sv.w << 16), __uint_as_float(uu.w & 0xffff0000u) * __uint_as_float(sv.w & 0xffff0000u));
            *(v4u*)((char*)ugp + (size_t)i * 65536 + voffu) = w;
        }
        __syncthreads();
        if (nxt >= total) break;
        ui = nxt;
    }
#undef SP_GVP
#undef SP_LOADGV
}

#ifndef PROBE_SITE
#define PROBE_SITE (-1)
#endif
constexpr size_t WS_CTL = 500 * MiB, CTL_BYTES = 16384;
constexpr size_t WS_DUMMY = 468 * MiB;
struct Params {
    const float* xp; const float* xs; const float* norm_g; const float* final_g;
    const float* a_w_in; const float* a_q_norm; const float* a_kv_norm; const float* a_w_q_up; const float* a_w_kv_up; const float* a_w_out;
    const float* b_w_in; const float* b_ln_g; const float* b_ln_b; const float* b_w_s; const float* b_b_s; const float* b_w_out;
    float* out; unsigned char* ws; int ph_lo, ph_hi, probe, pad;
};

#define PARG(f) ({ const __attribute__((address_space(4))) Params* q_ = (const __attribute__((address_space(4))) Params*)__builtin_amdgcn_kernarg_segment_ptr(); asm volatile("" : "+s"(q_)); q_->f; })
#define WSP(off) (PARG(ws) + (off))
__global__ void __launch_bounds__(NTHR, 2) mk_fwd(Params Punused) {
    extern __shared__ __attribute__((aligned(16))) unsigned char lds[];
    cg::grid_group grid = cg::this_grid();
    const int wave = __builtin_amdgcn_readfirstlane((int)threadIdx.x >> 6);
#define MK_LANE() ({ int l_; asm volatile("v_mbcnt_lo_u32_b32 %0, -1, 0\n\tv_mbcnt_hi_u32_b32 %0, -1, %0" : "=v"(l_)); l_; })
    const int G = gridDim.x, bid = blockIdx.x;
    const int gw = bid * NWAVES + wave, NGW = G * NWAVES;
    const int lo = PARG(ph_lo), hi = PARG(ph_hi);
    int k = 0;
    { volatile LAS unsigned* misc = (volatile LAS unsigned*)((LAS unsigned char*)lds + LDS_MISC); if (threadIdx.x < 4) misc[threadIdx.x] = 0u; __syncthreads(); }
    const XcdBarrier xbar = xcd_barrier_post((unsigned*)WSP(WS_CTL), (volatile LAS unsigned*)((LAS unsigned char*)lds + LDS_MISC), threadIdx.x == 0);
    if (PARG(ph_hi) < 0) grid.sync();
    const int probe = PARG(probe);
#define REP(site) for (int rep = (probe == (site) ? 0 : 1); rep < 2; ++rep)
#define PH_ON (k >= lo && k < hi)
#define PH_NEXT do { ++k; if (k > lo && k < hi) { xcd_barrier(xbar, wave == 0 && MK_LANE() == 0); } } while (0)
#define ROPE ((f32x2*)WSP(WS_ROPE))
#define STATS ((pg8::fx_t*)WSP(WS_STATS))
#define H ((bf16*)WSP(WS_H))
#define XBA ((bf16*)PARG(out))
#define Qb ((bf16*)WSP(WS_H))
#define GATE ((bf16*)WSP(WS_GATE))
#define QLAT ((bf16*)WSP(WS_QLAT))
#define KVLAT ((bf16*)WSP(WS_KVLAT))
#define KROPE ((bf16*)WSP(WS_KROPE))
#define KVb ((bf16*)WSP(WS_KV))
#define Q_0 ((bf16*)WSP(WS_H))
#define Q_1 ((bf16*)WSP(WS_Q1))
#define KV_0 ((bf16*)WSP(WS_KV))
#define KV_1 ((bf16*)((unsigned char*)PARG(out) + 96 * MiB))
#define GV_0 ((bf16*)WSP(WS_GV))
#define GV_1 ((bf16*)((unsigned char*)PARG(out) + 96 * MiB))
#define UG ((bf16*)WSP(WS_UG))
#define GV ((bf16*)WSP(WS_GV))

    if (PH_ON) REP(0) {
        const int lane = MK_LANE(), tid = wave * 64 + lane;
        LAS float* scr = (LAS float*)((LAS unsigned char*)lds + wave * 16384);
        constexpr int I_AIN = 16 * 56, I_QUP = 6 * 48, I_KVUP = 4 * 64, I_AOUT = 16 * 32, I_BIN = 16 * 192, I_BOUT = 32 * 32;
        constexpr int I_LAYER = I_AIN + I_QUP + I_KVUP + I_AOUT + I_BIN + I_BOUT;
        for (int it = gw; it < 2 * I_LAYER; it += NGW) {
            const int j = it / I_LAYER; int r = it % I_LAYER;
            if (r < I_AIN) { transpose_item(PARG(a_w_in) + (size_t)j * 1024 * 1728, 1024, 1728, 1792, (bf16*)(WSP(0) + WS_AIN) + (size_t)j * 1792 * 1024, scr, r, lane, 1, PARG(norm_g) + (2 * j) * DM); continue; } r -= I_AIN;
            if (r < I_QUP) { transpose_item(PARG(a_w_q_up) + (size_t)j * 384 * 1536, 384, 1536, 1536, (bf16*)(WSP(0) + WS_QUP) + (size_t)j * 1536 * 384, scr, r, lane, 2, PARG(a_q_norm) + j * 384); continue; } r -= I_QUP;
            if (r < I_KVUP) { transpose_item(PARG(a_w_kv_up) + (size_t)j * 256 * 2048, 256, 2048, 2048, (bf16*)(WSP(0) + WS_KVUP) + (size_t)j * 2048 * 256, scr, r, lane, 0, PARG(a_kv_norm) + j * 256); continue; } r -= I_KVUP;
            if (r < I_AOUT) { transpose_item(PARG(a_w_out) + (size_t)j * 1024 * 1024, 1024, 1024, 1024, (bf16*)(WSP(0) + WS_AOUT) + (size_t)j * 1024 * 1024, scr, r, lane, 0, nullptr); continue; } r -= I_AOUT;
            if (r < I_BIN) { transpose_item(PARG(b_w_in) + (size_t)j * 1024 * 6144, 1024, 6144, 6144, (bf16*)(WSP(0) + WS_BIN) + (size_t)j * 6144 * 1024, scr, r, lane, 3, PARG(norm_g) + (2 * j + 1) * DM); continue; } r -= I_BIN;
            transpose_item(PARG(b_w_out) + (size_t)j * 2048 * 1024, 2048, 1024, 1024, (bf16*)(WSP(0) + WS_BOUT) + (size_t)j * 1024 * 2048, scr, r, lane, 0, nullptr);
        }
        const int gt = bid * NTHR + tid, NGT = G * NTHR;
        for (int i = gt; i < 2 * 8 * 128 * 128; i += NGT) ((bf16*)(WSP(0) + WS_WS))[i] = (bf16)f2bf(PARG(b_w_s)[i]);
        for (int i = gt; i < 12 * M_TOT; i += NGT) STATS[i + (i >= 8 * M_TOT ? M_TOT : 0)] = 0ull;
        for (int i = gt; i < 8192 * 32; i += NGT) {
            const int pos = i >> 5, ii = i & 31;
            const float inv = (float)exp2(-(double)ii * (13.287712379549449 / 32.0));
            const float ang = (float)pos * inv;
            const double t = (double)ang * 0.15915494309189535; const float fr = (float)(t - rint(t));
            ROPE[i] = (f32x2){__builtin_amdgcn_cosf(fr), __builtin_amdgcn_sinf(fr)};
        }
        norm_phase(PARG(xp), PARG(xs) - (size_t)M_G0 * DM, PARG(norm_g), XBA, STATS + (size_t)8 * M_TOT, gw, NGW, lane);
    }
    PH_NEXT;

#pragma nounroll
    for (int L = 0; L < 4; ++L) {
        const int j = L >> 1;
        if ((L & 1) == 0) {
            pg8::fx_t* ssq_q = STATS + (size_t)(0 + j) * M_TOT; pg8::fx_t* ssq_kv = STATS + (size_t)(2 + j) * M_TOT;
            if (PH_ON) {
                pg8::Gemm g{XBA, (const bf16*)(WSP(0) + WS_AIN) + (size_t)j * 1792 * 1024, M_TOT, 1792, 1024}; pg8::StaticOrder S; S.init(M_TOT, 1792, G, bid);
                pg8::EpiAIn E{QLAT, KVLAT, KROPE, GATE, ssq_q, ssq_kv, (const pg8::f32x2*)ROPE, STATS + (size_t)(8 + L) * M_TOT};
                pg8::gemm_phase<pg8::EpiAIn, pg8::StaticOrder, true, true>((LAS unsigned char*)lds, g, S, E, wave * 64 + MK_LANE());
            }
            PH_NEXT;
            if (PH_ON) {
                { pg8::Gemm g{QLAT, (const bf16*)(WSP(0) + WS_QUP) + (size_t)j * 1536 * 384, M_TOT, 1536, 384}; pg8::StaticOrder S; S.init(M_TOT, 1536, G, bid);
                  pg8::EpiQUp E{Q_0, Q_1 - (size_t)M_G0 * 1536, ssq_q, (const pg8::f32x2*)ROPE};
                  pg8::gemm_phase<pg8::EpiQUp, pg8::StaticOrder, true, false>((LAS unsigned char*)lds, g, S, E, wave * 64 + MK_LANE()); }
                { pg8::Gemm g{KVLAT, (const bf16*)(WSP(0) + WS_KVUP) + (size_t)j * 2048 * 256, M_TOT, 2048, 256}; pg8::StaticOrder S; S.init(M_TOT, 2048, G, bid);
                  pg8::EpiKvUp E{KV_0, KV_1 - (size_t)M_G0 * 2048, ssq_kv};
                  pg8::gemm_phase<pg8::EpiKvUp, pg8::StaticOrder, true, false>((LAS unsigned char*)lds, g, S, E, wave * 64 + MK_LANE()); }
            }
            PH_NEXT;
            if (PH_ON) {
#pragma nounroll
                for (int gi = 0; gi < 2; ++gi) {
                    const int grow0 = gi ? M_G0 : 0;
                    const int seq = gi ? 8192 : 4096, nb = gi ? 2 : 8, nqb = seq / 256, total = nb * 8 * nqb;
                    for (int i = 0; i * G + bid < total; ++i) {
                        int pair, qb;
                        if (G == 256) { const int xcd = bid & 7, slot = bid >> 3, ppx = (256 / nqb) / 8; pair = (i * 8 + xcd) * ppx + slot / nqb; qb = slot % nqb; }
                        else { const int ui = i * G + bid; pair = ui / nqb; qb = ui % nqb; }
                        const int b = pair >> 3, h = pair & 7; const size_t lrow_b = (size_t)b * seq, qrow_l = lrow_b + (size_t)qb * 256;
                        const bf16* Qg = gi ? Q_1 : Q_0; const bf16* KVg = gi ? KV_1 : KV_0;
                        __syncthreads();
                        att::attn_unit(Qg + qrow_l * 1536 + h * 192, KVg + lrow_b * 2048 + h * 256, KVg + lrow_b * 2048 + h * 256 + 128, KROPE + ((size_t)grow0 + lrow_b) * 64,
                                       GATE + ((size_t)grow0 + qrow_l) * 1024 + h * 128, seq, (char*)lds, wave * 64 + MK_LANE());
                    }
                }
            }
            PH_NEXT;
            if (PH_ON) {
                pg8::Gemm g{GATE, (const bf16*)(WSP(0) + WS_AOUT) + (size_t)j * 1024 * 1024, M_TOT, 1024, 1024}; pg8::StaticOrder S; S.init(M_TOT, 1024, G, bid);
                pg8::EpiResid E{XBA, H, (float*)nullptr, STATS + (size_t)(8 + L + 1) * M_TOT};
                pg8::gemm_phase<pg8::EpiResid, pg8::StaticOrder, true, true>((LAS unsigned char*)lds, g, S, E, wave * 64 + MK_LANE());
            }
            PH_NEXT;
        } else {
            pg8::fx_t* s1 = STATS + (size_t)(4 + j) * M_TOT; pg8::fx_t* s2 = STATS + (size_t)(6 + j) * M_TOT;
            if (PH_ON) {
                pg8::Gemm g{H, (const bf16*)(WSP(0) + WS_BIN) + (size_t)j * 6144 * 1024, M_TOT, 6144, 1024}; pg8::StaticOrder S; S.init(M_TOT, 6144, G, bid);
                pg8::EpiBIn E{GV_0, GV_1 - (size_t)M_G0 * 2048, UG, s1, s2, STATS + (size_t)(8 + L) * M_TOT};
                pg8::gemm_phase<pg8::EpiBIn, pg8::StaticOrder, true, true>((LAS unsigned char*)lds, g, S, E, wave * 64 + MK_LANE());
            }
            PH_NEXT;
            if (PH_ON) {
                spatial_phase((char*)lds, GV_0, GV_1, UG, s1, s2, (const bf16*)(WSP(0) + WS_WS) + (size_t)j * 8 * 128 * 128, PARG(b_ln_g) + j * 2048, PARG(b_ln_b) + j * 2048, PARG(b_b_s) + j * 8 * 128, bid, G, wave * 64 + MK_LANE());
            }
            PH_NEXT;
            if (PH_ON) REP(7) {
                pg8::Gemm g{UG, (const bf16*)(WSP(0) + WS_BOUT) + (size_t)j * 1024 * 2048, M_TOT, 1024, 2048}; pg8::StaticOrder S; S.init(M_TOT, 1024, G, bid);
                pg8::EpiResid E{H, L < 3 ? XBA : H, (float*)nullptr, rep ? STATS + (size_t)(8 + L + 1) * M_TOT : (pg8::fx_t*)WSP(WS_DUMMY)};
                pg8::gemm_phase<pg8::EpiResid, pg8::StaticOrder, true, true>((LAS unsigned char*)lds, g, S, E, wave * 64 + MK_LANE());
            }
            PH_NEXT;
        }
    }
    if (PH_ON) {
        const int lane = MK_LANE();
        float* outp = PARG(out); const f32x4* gr = (const f32x4*)PARG(final_g);
        const pg8::fx_t* ssqf = STATS + (size_t)12 * M_TOT;
        f32x4 g0[2], g1[2];
#pragma unroll
        for (int jj = 0; jj < 2; ++jj) { g0[jj] = gr[(64 * jj + lane) * 2]; g1[jj] = gr[(64 * jj + lane) * 2 + 1]; }
        int m = gw;
        for (; m + 7 * NGW < M_TOT; m += 8 * NGW) {
            v4u xb[8][2]; float rs_[8];
#pragma unroll
            for (int r = 0; r < 8; ++r) { const v4u* xr = (const v4u*)(H + (size_t)(m + r * NGW) * DM); xb[r][0] = xr[lane]; xb[r][1] = xr[64 + lane]; rs_[r] = pg8::fx_get(ssqf + m + r * NGW); }
#pragma unroll
            for (int r = 0; r < 8; ++r) { const float rstd = 1.0f / sqrtf(rs_[r] * (1.0f / 1024.0f) + 1e-6f); f32x4* orow = (f32x4*)(outp + (size_t)(m + r * NGW) * DM);
#pragma unroll
                for (int jj = 0; jj < 2; ++jj) { const v4u x = xb[r][jj];
                    const f32x4 x0 = {__uint_as_float(x.x << 16), __uint_as_float(x.x & 0xffff0000u), __uint_as_float(x.y << 16), __uint_as_float(x.y & 0xffff0000u)};
                    const f32x4 x1 = {__uint_as_float(x.z << 16), __uint_as_float(x.z & 0xffff0000u), __uint_as_float(x.w << 16), __uint_as_float(x.w & 0xffff0000u)};
                    orow[(64 * jj + lane) * 2] = x0 * rstd * g0[jj]; orow[(64 * jj + lane) * 2 + 1] = x1 * rstd * g1[jj]; } }
        }
        for (; m < M_TOT; m += NGW) { const float rstd = 1.0f / sqrtf(pg8::fx_get(ssqf + m) * (1.0f / 1024.0f) + 1e-6f); const v4u* xr = (const v4u*)(H + (size_t)m * DM); f32x4* orow = (f32x4*)(outp + (size_t)m * DM);
#pragma unroll
            for (int jj = 0; jj < 2; ++jj) { const v4u x = xr[64 * jj + lane];
                const f32x4 x0 = {__uint_as_float(x.x << 16), __uint_as_float(x.x & 0xffff0000u), __uint_as_float(x.y << 16), __uint_as_float(x.y & 0xffff0000u)};
                const f32x4 x1 = {__uint_as_float(x.z << 16), __uint_as_float(x.z & 0xffff0000u), __uint_as_float(x.w << 16), __uint_as_float(x.w & 0xffff0000u)};
                orow[(64 * jj + lane) * 2] = x0 * rstd * g0[jj]; orow[(64 * jj + lane) * 2 + 1] = x1 * rstd * g1[jj]; } }
    }
}

extern "C" void kernel_launch(void* const* d_in, const int* in_sizes, int n_in, void* d_out, int out_size, void* d_ws, size_t ws_size, hipStream_t stream) {
    static int grid = 0;
    if (grid == 0) {
        if (n_in != 16 || out_size != M_TOT * DM || ws_size < 510 * MiB) { fprintf(stderr, "kernel_launch: unexpected shapes: n_in %d out %d ws %zu (need >= %zu)\n", n_in, out_size, ws_size, (size_t)WS_END); grid = -1; return; }
        int dev = 0, cus = 0, per_cu = 0;
        hipGetDevice(&dev); hipDeviceGetAttribute(&cus, hipDeviceAttributeMultiprocessorCount, dev);
        if (hipFuncSetAttribute((const void*)mk_fwd, hipFuncAttributeMaxDynamicSharedMemorySize, LDS_BYTES) != hipSuccess) { fprintf(stderr, "kernel_launch: hipFuncSetAttribute failed\n"); grid = -1; return; }
        if (hipOccupancyMaxActiveBlocksPerMultiprocessor(&per_cu, (const void*)mk_fwd, NTHR, LDS_BYTES) != hipSuccess || per_cu < 1) { fprintf(stderr, "kernel_launch: occupancy query gave %d\n", per_cu); per_cu = 1; }
        (void)hipGetLastError();
        grid = cus;
        fprintf(stderr, "kernel_launch: cus %d per_cu %d grid %d\n", cus, per_cu, grid);
    }
    if (grid < 0) return;
    if (hipMemsetAsync((char*)d_ws + WS_CTL, 0, CTL_BYTES, stream) != hipSuccess) { fprintf(stderr, "kernel_launch: memset failed\n"); return; }
    Params p{};
    p.xp = (const float*)d_in[0]; p.xs = (const float*)d_in[1]; p.norm_g = (const float*)d_in[2]; p.final_g = (const float*)d_in[3];
    p.a_w_in = (const float*)d_in[4]; p.a_q_norm = (const float*)d_in[5]; p.a_kv_norm = (const float*)d_in[6]; p.a_w_q_up = (const float*)d_in[7]; p.a_w_kv_up = (const float*)d_in[8]; p.a_w_out = (const float*)d_in[9];
    p.b_w_in = (const float*)d_in[10]; p.b_ln_g = (const float*)d_in[11]; p.b_ln_b = (const float*)d_in[12]; p.b_w_s = (const float*)d_in[13]; p.b_b_s = (const float*)d_in[14]; p.b_w_out = (const float*)d_in[15];
    p.out = (float*)d_out; p.ws = (unsigned char*)d_ws; p.ph_lo = 0; p.ph_hi = 1000; p.probe = PROBE_SITE;
    void* args[] = {&p};
    const hipError_t e = hipLaunchCooperativeKernel((const void*)mk_fwd, dim3(grid), dim3(NTHR), args, LDS_BYTES, stream);
    if (e != hipSuccess) fprintf(stderr, "kernel_launch: cooperative launch failed: %s (grid %d)\n", hipGetErrorString(e), grid);
}
```
